# Optimizing an MI355X kernel written in HIP

```python
import math
import jax, jax.numpy as jnp
from jax import lax
import numpy as np

D_MODEL = 1024
BATCH = 4
SEQ = 4096
DEPTH = 1
DEC_BATCH = 32
DEC_SEQ = 1
PAST_LEN = 8192
PAGE_SIZE = 128

ATTN_WIDTH = D_MODEL // 2
MLSTM_WIDTH = D_MODEL - ATTN_WIDTH
A_HEAD_DIM = 64
A_HEADS = ATTN_WIDTH // A_HEAD_DIM
M_HEADS = 4
M_HEAD_DIM = MLSTM_WIDTH // M_HEADS
MOBA_BLOCK = 256
MOBA_TOPK = 3
Q_CHUNK = 64
MLSTM_CHUNK = 64
D_FF = 4 * D_MODEL
RMS_EPS = 1e-6
NEG_INF = float('-inf')
OFF_QA = 0
OFF_KA = ATTN_WIDTH
OFF_VA = 2 * ATTN_WIDTH
OFF_QM = 3 * ATTN_WIDTH
OFF_KM = OFF_QM + MLSTM_WIDTH
OFF_VM = OFF_QM + 2 * MLSTM_WIDTH
OFF_OM = OFF_QM + 3 * MLSTM_WIDTH
OFF_G = OFF_QM + 4 * MLSTM_WIDTH
IN_WIDTH = OFF_G + 2 * M_HEADS

kernel_name = 'hymba_moba_mlstm_step'


def rmsnorm(x, w):
    xf = x.astype(jnp.float32)
    y = xf * lax.rsqrt(jnp.mean(xf * xf, axis=-1, keepdims=True) + RMS_EPS)
    return (y * w.astype(jnp.float32)).astype(x.dtype)


def moba_attention(q, k, v, q_start):
    B, Lq, H, dh = q.shape
    L = k.shape[1]
    scale = dh ** -0.5
    cq = min(Q_CHUNK, Lq)
    n_chunks = -(-Lq // cq)
    lq_pad = n_chunks * cq
    lk_pad = -(-(q_start + lq_pad) // MOBA_BLOCK) * MOBA_BLOCK
    q_p = jnp.pad(q, ((0, 0), (0, lq_pad - Lq), (0, 0), (0, 0)))
    k_p = jnp.pad(k, ((0, 0), (0, lk_pad - L), (0, 0), (0, 0)))
    v_p = jnp.pad(v, ((0, 0), (0, lk_pad - L), (0, 0), (0, 0)))
    n_full = L // MOBA_BLOCK
    top = min(MOBA_TOPK, n_full)
    if top > 0:
        kb = k[:, :n_full * MOBA_BLOCK].reshape(B, n_full, MOBA_BLOCK, H, dh).transpose(0, 3, 1, 2, 4)
        vb = v[:, :n_full * MOBA_BLOCK].reshape(B, n_full, MOBA_BLOCK, H, dh).transpose(0, 3, 1, 2, 4)
        k_mean = jnp.mean(kb.astype(jnp.float32), axis=3)
        bi = jnp.arange(B)[:, None, None, None]
        hi = jnp.arange(H)[None, :, None, None]
    qc = q_p.reshape(B, n_chunks, cq, H, dh).transpose(1, 0, 3, 2, 4)

    def one_chunk(args):
        q_blk, c = args
        start = q_start + c * cq
        qpos = start + jnp.arange(cq)
        own_start = (start // MOBA_BLOCK) * MOBA_BLOCK
        k_own = lax.dynamic_slice_in_dim(k_p, own_start, MOBA_BLOCK, axis=1)
        v_own = lax.dynamic_slice_in_dim(v_p, own_start, MOBA_BLOCK, axis=1)
        kpos = own_start + jnp.arange(MOBA_BLOCK)
        s_own = jnp.einsum('bhtd,bshd->bhts', q_blk, k_own, preferred_element_type=jnp.float32) * scale
        s_own = jnp.where(kpos[None, None, None, :] <= qpos[None, None, :, None], s_own, NEG_INF)
        if top == 0:
            p_own = jax.nn.softmax(s_own, axis=-1).astype(v.dtype)
            return jnp.einsum('bhts,bshd->bhtd', p_own, v_own)
        cur_blk = qpos // MOBA_BLOCK
        gate = jnp.einsum('bhtd,bhnd->bhtn', q_blk.astype(jnp.float32), k_mean)
        past = jnp.arange(n_full)[None, :] < cur_blk[:, None]
        gate = jnp.where(past[None, None], gate, NEG_INF)
        _, idx = lax.top_k(gate, top)
        sel_ok = idx < cur_blk[None, None, :, None]
        k_sel = kb[bi, hi, idx]
        v_sel = vb[bi, hi, idx]
        s_sel = jnp.einsum('bhtd,bhtjsd->bhtjs', q_blk, k_sel, preferred_element_type=jnp.float32) * scale
        s_sel = jnp.where(sel_ok[..., None], s_sel, NEG_INF).reshape(B, H, cq, top * MOBA_BLOCK)
        p = jax.nn.softmax(jnp.concatenate([s_sel, s_own], axis=-1), axis=-1)
        p_sel = p[..., :top * MOBA_BLOCK].reshape(B, H, cq, top, MOBA_BLOCK).astype(v.dtype)
        p_own = p[..., top * MOBA_BLOCK:].astype(v.dtype)
        return (jnp.einsum('bhtjs,bhtjsd->bhtd', p_sel, v_sel)
                + jnp.einsum('bhts,bshd->bhtd', p_own, v_own))

    outs = lax.map(one_chunk, (qc, jnp.arange(n_chunks)))
    return outs.transpose(1, 0, 3, 2, 4).reshape(B, lq_pad, H, dh)[:, :Lq]


def mlstm_chunkwise(q, k, v, i_pre, f_pre, C0, n0, m0):
    B, S, NH, dh = q.shape
    cs = min(MLSTM_CHUNK, S)
    nc = -(-S // cs)
    sp = nc * cs
    valid = jnp.arange(sp) < S
    f32 = jnp.float32

    def pad(a):
        return jnp.pad(a, [(0, 0), (0, sp - S)] + [(0, 0)] * (a.ndim - 2))

    def to_chunks(a):
        return pad(a).astype(f32).reshape(B, nc, cs, NH, dh).transpose(1, 0, 3, 2, 4)

    qc = to_chunks(q) * (dh ** -0.5)
    kc = to_chunks(k)
    vc = to_chunks(v)
    li = jnp.where(valid[None, :, None], pad(i_pre).astype(f32), NEG_INF)
    lf = jnp.where(valid[None, :, None], jax.nn.log_sigmoid(pad(f_pre).astype(f32)), 0.0)
    li = li.reshape(B, nc, cs, NH).transpose(1, 0, 3, 2)
    lf = lf.reshape(B, nc, cs, NH).transpose(1, 0, 3, 2)
    tri = jnp.tril(jnp.ones((cs, cs), dtype=bool))

    def step(carry, inp):
        C, n, m = carry
        qb, kb, vb, lib, lfb = inp
        b = jnp.cumsum(lfb, axis=-1)
        D = jnp.where(tri, b[..., :, None] - b[..., None, :] + lib[..., None, :], NEG_INF)
        m_t = jnp.maximum(b + m[..., None], jnp.max(D, axis=-1))
        W = jnp.exp(D - m_t[..., None])
        decay = jnp.exp(b + m[..., None] - m_t)
        qk = jnp.einsum('bhtd,bhsd->bhts', qb, kb) * W
        num = (jnp.einsum('bhts,bhsd->bhtd', qk, vb)
               + decay[..., None] * jnp.einsum('bhtd,bhde->bhte', qb, C))
        den = jnp.sum(qk, axis=-1) + decay * jnp.einsum('bhtd,bhd->bht', qb, n)
        h = num / jnp.maximum(jnp.abs(den), jnp.exp(-m_t))[..., None]
        m_new = m_t[..., -1]
        w_end = jnp.exp(b[..., -1:] - b + lib - m_new[..., None])
        dec_end = jnp.exp(b[..., -1] + m - m_new)
        C_new = dec_end[..., None, None] * C + jnp.einsum('bhs,bhsd,bhse->bhde', w_end, kb, vb)
        n_new = dec_end[..., None] * n + jnp.einsum('bhs,bhsd->bhd', w_end, kb)
        return (C_new, n_new, m_new), h

    carry0 = (C0.astype(f32), n0.astype(f32), m0.astype(f32))
    (C, n, m), hs = lax.scan(step, carry0, (qc, kc, vc, li, lf))
    h = hs.transpose(1, 0, 3, 2, 4).reshape(B, sp, NH, dh)[:, :S]
    return h, C, n, m


def hybrid_layer(x, k_past, v_past, C0, n0, m0, q_start,
                 ln1_w, w_in, b_gates, mlstm_norm_w, w_out, ln2_w, w_up, w_down):
    B, S, _ = x.shape
    xn = rmsnorm(x, ln1_w)
    z = xn @ w_in
    qa = z[..., OFF_QA:OFF_KA].reshape(B, S, A_HEADS, A_HEAD_DIM)
    ka = z[..., OFF_KA:OFF_VA].reshape(B, S, A_HEADS, A_HEAD_DIM)
    va = z[..., OFF_VA:OFF_QM].reshape(B, S, A_HEADS, A_HEAD_DIM)
    qm = z[..., OFF_QM:OFF_KM].reshape(B, S, M_HEADS, M_HEAD_DIM)
    km = z[..., OFF_KM:OFF_VM].reshape(B, S, M_HEADS, M_HEAD_DIM)
    vm = z[..., OFF_VM:OFF_OM].reshape(B, S, M_HEADS, M_HEAD_DIM)
    om = z[..., OFF_OM:OFF_G]
    gates = z[..., OFF_G:].astype(jnp.float32) + b_gates.astype(jnp.float32)
    i_pre = gates[..., :M_HEADS]
    f_pre = gates[..., M_HEADS:]
    if k_past is None:
        k_all, v_all = ka, va
    else:
        k_all = jnp.concatenate([k_past.astype(ka.dtype), ka], axis=1)
        v_all = jnp.concatenate([v_past.astype(va.dtype), va], axis=1)
    attn = moba_attention(qa, k_all, v_all, q_start).reshape(B, S, ATTN_WIDTH)
    h, C, n, m = mlstm_chunkwise(qm, km, vm, i_pre, f_pre, C0, n0, m0)
    h = h * lax.rsqrt(jnp.mean(h * h, axis=-1, keepdims=True) + RMS_EPS)
    h = h * mlstm_norm_w.astype(jnp.float32).reshape(M_HEADS, M_HEAD_DIM)
    h = (h.reshape(B, S, MLSTM_WIDTH) * jax.nn.sigmoid(om.astype(jnp.float32))).astype(x.dtype)
    mix = jnp.concatenate([attn.astype(x.dtype), h], axis=-1)
    x = x + mix @ w_out
    hn = rmsnorm(x, ln2_w)
    x = x + jnp.square(jax.nn.relu(hn @ w_up)) @ w_down
    return x, ka, va, C, n, m


def setup_inputs(seed: int = 0) -> dict:
    key = jax.random.key(seed)
    ks = jax.random.split(key, 20)
    f32 = jnp.float32
    n_pages = PAST_LEN // PAGE_SIZE
    n_phys = (DEC_BATCH * n_pages * 5) // 4
    nrm = jax.random.normal
    x_prompt = nrm(ks[0], (BATCH, SEQ, D_MODEL), f32)
    x_sample = nrm(ks[1], (DEC_BATCH, DEC_SEQ, D_MODEL), f32)
    cache_k = nrm(ks[2], (DEPTH, n_phys, PAGE_SIZE, A_HEADS, A_HEAD_DIM), f32)
    cache_v = nrm(ks[3], (DEPTH, n_phys, PAGE_SIZE, A_HEADS, A_HEAD_DIM), f32)
    page_table = jax.random.permutation(ks[4], n_phys)[:DEC_BATCH * n_pages].reshape(DEC_BATCH, n_pages).astype(jnp.int32)
    state_C = 2.0 * nrm(ks[5], (DEPTH, DEC_BATCH, M_HEADS, M_HEAD_DIM, M_HEAD_DIM), f32)
    state_n = 2.0 * nrm(ks[6], (DEPTH, DEC_BATCH, M_HEADS, M_HEAD_DIM), f32)
    state_m = nrm(ks[7], (DEPTH, DEC_BATCH, M_HEADS), f32)
    ln1_w = 1.0 + 0.05 * nrm(ks[8], (DEPTH, D_MODEL), f32)
    w_in = nrm(ks[9], (DEPTH, D_MODEL, IN_WIDTH), f32) * D_MODEL ** -0.5
    b_i = 0.1 * nrm(ks[10], (DEPTH, M_HEADS), f32)
    b_f = 3.0 + 0.5 * nrm(ks[11], (DEPTH, M_HEADS), f32)
    b_gates = jnp.concatenate([b_i, b_f], axis=-1)
    mlstm_norm_w = 1.0 + 0.05 * nrm(ks[12], (DEPTH, MLSTM_WIDTH), f32)
    w_out = nrm(ks[13], (DEPTH, ATTN_WIDTH + MLSTM_WIDTH, D_MODEL), f32) * D_MODEL ** -0.5
    ln2_w = 1.0 + 0.05 * nrm(ks[14], (DEPTH, D_MODEL), f32)
    w_up = nrm(ks[15], (DEPTH, D_MODEL, D_FF), f32) * D_MODEL ** -0.5
    w_down = nrm(ks[16], (DEPTH, D_FF, D_MODEL), f32) * D_FF ** -0.5
    lnf_w = 1.0 + 0.05 * nrm(ks[17], (D_MODEL,), f32)
    return {'x_prompt': x_prompt, 'x_sample': x_sample, 'cache_k': cache_k, 'cache_v': cache_v,
            'page_table': page_table, 'state_C': state_C, 'state_n': state_n, 'state_m': state_m,
            'ln1_w': ln1_w, 'w_in': w_in, 'b_gates': b_gates, 'mlstm_norm_w': mlstm_norm_w,
            'w_out': w_out, 'ln2_w': ln2_w, 'w_up': w_up, 'w_down': w_down, 'lnf_w': lnf_w}


def reference(x_prompt, x_sample, cache_k, cache_v, page_table, state_C, state_n, state_m,
              ln1_w, w_in, b_gates, mlstm_norm_w, w_out, ln2_w, w_up, w_down, lnf_w):
    Bp = x_prompt.shape[0]
    Bs = x_sample.shape[0]
    past_len = page_table.shape[1] * PAGE_SIZE
    xp, xs = x_prompt, x_sample
    kp_l, vp_l, Cp_l, np_l, mp_l = [], [], [], [], []
    ks_l, vs_l, Cs_l, ns_l, ms_l = [], [], [], [], []
    for l in range(DEPTH):
        lw = (ln1_w[l], w_in[l], b_gates[l], mlstm_norm_w[l], w_out[l], ln2_w[l], w_up[l], w_down[l])
        C0 = jnp.zeros((Bp, M_HEADS, M_HEAD_DIM, M_HEAD_DIM), jnp.float32)
        n0 = jnp.zeros((Bp, M_HEADS, M_HEAD_DIM), jnp.float32)
        m0 = jnp.zeros((Bp, M_HEADS), jnp.float32)
        xp, kp, vp, Cp, n_p, mp = hybrid_layer(xp, None, None, C0, n0, m0, 0, *lw)
        k_past = cache_k[l][page_table].reshape(Bs, past_len, A_HEADS, A_HEAD_DIM)
        v_past = cache_v[l][page_table].reshape(Bs, past_len, A_HEADS, A_HEAD_DIM)
        xs, ksm, vsm, Cs, n_s, ms = hybrid_layer(xs, k_past, v_past, state_C[l], state_n[l], state_m[l],
                                                 past_len, *lw)
        kp_l.append(kp); vp_l.append(vp); Cp_l.append(Cp); np_l.append(n_p); mp_l.append(mp)
        ks_l.append(ksm); vs_l.append(vsm); Cs_l.append(Cs); ns_l.append(n_s); ms_l.append(ms)
    y_prompt = rmsnorm(xp, lnf_w)
    y_sample = rmsnorm(xs, lnf_w)
    return (y_prompt, y_sample,
            jnp.stack(kp_l), jnp.stack(vp_l), jnp.stack(Cp_l), jnp.stack(np_l), jnp.stack(mp_l),
            jnp.stack(ks_l), jnp.stack(vs_l), jnp.stack(Cs_l), jnp.stack(ns_l), jnp.stack(ms_l))
```

```cpp
#include <hip/hip_runtime.h>
#include <hip/hip_bf16.h>
#include <cstdio>
#include <cstdint>
#include <cmath>
namespace pg8 {
#define PG8_LAS __attribute__((address_space(3)))
typedef unsigned short bf16_t;
typedef short bf16x8 __attribute__((ext_vector_type(8)));
typedef float f32x4 __attribute__((ext_vector_type(4)));
typedef unsigned u32x4 __attribute__((ext_vector_type(4)));
constexpr int BM = 256, BK = 64, HALF = 128, HTB = HALF * BK * 2  , STAGE_BYTES = 8 * HTB, NXCD = 8, WGM = 8;

__host__ __device__ __forceinline__ int lds_byte(int r, int c) { const int st = (r >> 4) * 2 + (c >> 5), rr = r & 15, cc = c & 31, ob = rr * 64 + cc * 2; return st * 1024 + (ob ^ (((ob >> 9) & 1) << 5)); }
__host__ __device__ __forceinline__ void stage_rc(int b, int& R, int& C) { const int st = b / 1024, sb = b % 1024, swz = sb ^ (((sb >> 9) & 1) << 5); R = (st >> 1) * 16 + swz / 64; C = (st & 1) * 32 + (swz % 64) / 2; }
__host__ __device__ __forceinline__ int perm32(int rho) { const int n = rho >> 4, i = rho & 15; return 8 * (i >> 2) + 4 * n + (i & 3); }

struct Unit { int pm, pn; };
struct Gemm { const bf16_t* A; const bf16_t* Bt; int M, N, K; };

struct StaticOrder {
    int nM, nN, nwg, G, c;
    __host__ __device__ void init(int M, int N, int G_, int c_) { nM = M / BM; nN = N / BM; nwg = nM * nN; G = G_; c = c_; }
    __host__ __device__ bool next(int i, Unit& u) const {
        const long L = (long)i * G + c; if (L >= nwg) return false;
        int wgid = (int)L; { const int q = nwg / NXCD, r = nwg % NXCD, xcd = wgid % NXCD, off = wgid / NXCD; wgid = (xcd < r ? xcd * (q + 1) : r * (q + 1) + (xcd - r) * q) + off; }
        const int nig = WGM * nN, gid = wgid / nig, fm = gid * WGM, gsz = (nM - fm) < WGM ? (nM - fm) : WGM;
        u.pm = fm + ((wgid % nig) % gsz); u.pn = (wgid % nig) / gsz; return true;
    }
    __device__ __forceinline__ void a_ready(const Unit&) const {}
    __device__ __forceinline__ void done(const Unit&) const {}
};

__device__ __forceinline__ unsigned cvt_pk_bf16(float lo, float hi) { unsigned r; asm volatile("v_cvt_pk_bf16_f32 %0, %1, %2" : "=v"(r) : "v"(lo), "v"(hi)); return r; }
typedef unsigned u32x2 __attribute__((ext_vector_type(2)));

struct EpiZ {
    static constexpr bool PERM = true, AFTER_DRAIN = false;
    bf16_t* Z; size_t zstride; float qscale; float* kp; float* vp; float* ks; float* vs; float* kmean;
    __device__ __forceinline__ void operator()(const f32x4 (&acc)[2][2][4][2], const Unit& u, int wr, int wc, int fr, int fq) const {
        const int t = u.pn >> 1, colt = (u.pn & 1) * BM;
        bf16_t* base = Z + (size_t)t * zstride;
        const float sc = (t == 0) ? qscale : 1.f;
        const int lrow0 = wr * 64 + fr, col0 = colt + wc * 32 + 8 * fq;
        const bool kv = (t == 1 || t == 2);
        float* fdst = nullptr; int nvalid = 0;
        if (kv) { if (u.pm < 64) { fdst = (t == 1 ? kp : vp) + (size_t)u.pm * BM * 512; nvalid = BM; } else { fdst = (t == 1 ? ks : vs); nvalid = 32; } }
#pragma unroll
        for (int ai = 0; ai < 2; ++ai)
#pragma unroll
            for (int m = 0; m < 4; ++m) { const int lrow = lrow0 + ai * HALF + m * 16; bf16_t* rowp = base + (size_t)(u.pm * BM + lrow) * 512 + col0;
#pragma unroll
                for (int bj = 0; bj < 2; ++bj) { const f32x4 v0 = acc[ai][bj][m][0] * sc, v1 = acc[ai][bj][m][1] * sc;
                    u32x4 w; w.x = cvt_pk_bf16(v0[0], v0[1]); w.y = cvt_pk_bf16(v0[2], v0[3]); w.z = cvt_pk_bf16(v1[0], v1[1]); w.w = cvt_pk_bf16(v1[2], v1[3]);
                    *(u32x4*)(rowp + bj * HALF) = w;
                    if (kv && lrow < nvalid) { float* fp = fdst + (size_t)lrow * 512 + col0 + bj * HALF; *(f32x4*)fp = acc[ai][bj][m][0]; *(f32x4*)(fp + 4) = acc[ai][bj][m][1]; } } }
        if (t == 1 && u.pm < 64) {
            f32x4 cs[2][2];
#pragma unroll
            for (int bj = 0; bj < 2; ++bj)
#pragma unroll
                for (int n = 0; n < 2; ++n) { f32x4 s = acc[0][bj][0][n];
#pragma unroll
                    for (int m = 1; m < 4; ++m) s += acc[0][bj][m][n];
#pragma unroll
                    for (int m = 0; m < 4; ++m) s += acc[1][bj][m][n];
#pragma unroll
                    for (int i = 0; i < 4; ++i) { float x = s[i]; x += __shfl_xor(x, 1); x += __shfl_xor(x, 2); x += __shfl_xor(x, 4); x += __shfl_xor(x, 8); s[i] = x; }
                    cs[bj][n] = s; }
            if (fr == 0) { float* km = kmean + (size_t)u.pm * 512 + col0;
#pragma unroll
                for (int bj = 0; bj < 2; ++bj)
#pragma unroll
                    for (int n = 0; n < 2; ++n)
#pragma unroll
                        for (int i = 0; i < 4; ++i) __hip_atomic_fetch_add(km + bj * HALF + 4 * n + i, cs[bj][n][i] * (1.0f / 256.0f), __ATOMIC_RELAXED, __HIP_MEMORY_SCOPE_AGENT); }
        }
    }
};

struct EpiRes {
    static constexpr bool PERM = false, AFTER_DRAIN = false;
    const float* res; float* out; bf16_t* outb; float* ssq;
    __device__ __forceinline__ void operator()(const f32x4 (&acc)[2][2][4][2], const Unit& u, int wr, int wc, int fr, int fq) const {
        const int row0 = u.pm * BM + wr * 64 + fr, col0 = u.pn * BM + wc * 32 + 4 * fq;
#pragma unroll
        for (int ai = 0; ai < 2; ++ai)
#pragma unroll
            for (int m = 0; m < 4; ++m) { const int row = row0 + ai * HALF + m * 16; const size_t off = (size_t)row * 1024 + col0; float s = 0.f;
#pragma unroll
                for (int bj = 0; bj < 2; ++bj)
#pragma unroll
                    for (int n = 0; n < 2; ++n) { const f32x4 v = *(const f32x4*)(res + off + bj * HALF + n * 16) + acc[ai][bj][m][n];
                        *(f32x4*)(out + off + bj * HALF + n * 16) = v; s += (v[0] * v[0] + v[1] * v[1]) + (v[2] * v[2] + v[3] * v[3]);
                        if (outb) { u32x2 w; w.x = cvt_pk_bf16(v[0], v[1]); w.y = cvt_pk_bf16(v[2], v[3]); *(u32x2*)(outb + off + bj * HALF + n * 16) = w; } }
                s += __shfl_xor(s, 16); s += __shfl_xor(s, 32);
                if (fq == 0) ssq[(size_t)row * 16 + u.pn * 4 + wc] = s; }
    }
};

struct EpiUp {
    static constexpr bool PERM = true, AFTER_DRAIN = false;
    bf16_t* O; const float* ssq; float eps;
    __device__ __forceinline__ void operator()(const f32x4 (&acc)[2][2][4][2], const Unit& u, int wr, int wc, int fr, int fq) const {
        const int row0 = u.pm * BM + wr * 64 + fr, col0 = u.pn * BM + wc * 32 + 8 * fq;
#pragma unroll
        for (int ai = 0; ai < 2; ++ai)
#pragma unroll
            for (int m = 0; m < 4; ++m) { const int row = row0 + ai * HALF + m * 16;
                const f32x4 q = *(const f32x4*)(ssq + (size_t)row * 16 + 4 * fq); float s = (q[0] + q[1]) + (q[2] + q[3]);
                s += __shfl_xor(s, 16); s += __shfl_xor(s, 32);
                const float rs = 1.0f / sqrtf(s * (1.0f / 1024.0f) + eps);
                bf16_t* rowp = O + (size_t)row * 4096 + col0;
#pragma unroll
                for (int bj = 0; bj < 2; ++bj) { f32x4 v0 = acc[ai][bj][m][0] * rs, v1 = acc[ai][bj][m][1] * rs;
#pragma unroll
                    for (int i = 0; i < 4; ++i) { const float a = fmaxf(v0[i], 0.f), b = fmaxf(v1[i], 0.f); v0[i] = a * a; v1[i] = b * b; }
                    u32x4 w; w.x = cvt_pk_bf16(v0[0], v0[1]); w.y = cvt_pk_bf16(v0[2], v0[3]); w.z = cvt_pk_bf16(v1[0], v1[1]); w.w = cvt_pk_bf16(v1[2], v1[3]);
                    *(u32x4*)(rowp + bj * HALF) = w; } }
    }
};

template <class Epi, class Sched, bool ALIGN_EPI = false, bool SP2 = false>
__device__ __forceinline__ void gemm_phase(PG8_LAS unsigned char* lds, const Gemm g, const Sched& S, const Epi& E) {
    const int tid = threadIdx.x, wid = __builtin_amdgcn_readfirstlane(tid >> 6), lane = tid & 63, wr = wid >> 2, wc = wid & 3, fr = lane & 15, fq = lane >> 4;
    const int K = g.K, nt = K / BK;
    unsigned voffA[2], voffB[2];
#pragma unroll
    for (int i = 0; i < 2; ++i) { int R, C; stage_rc(tid * 16 + i * 8192, R, C); const int Rb = Epi::PERM ? ((R & ~31) + perm32(R & 31)) : R;
        voffA[i] = (unsigned)(R * K + C) * 2u; voffB[i] = (unsigned)(Rb * K + C) * 2u; }
    const size_t kstep = (size_t)(BK * 2);
    const size_t hstep = (size_t)HALF * K * 2;
    const size_t tstep = 2 * hstep;
    const unsigned ldsw = (unsigned)wid * 1024u;
    const int aoff = lds_byte(wr * 64 + fr, fq * 8), boff = lds_byte(wc * 32 + fr, fq * 8);
#define PG8_SA(b, h) (((b) * 2 + (h)) * HTB)
#define PG8_SB(b, h) ((4 + (b) * 2 + (h)) * HTB)
#define PG8_STAGE(bufoff, gbase, voff) do { _Pragma("unroll") for (int _i = 0; _i < 2; ++_i) \
        __builtin_amdgcn_global_load_lds((const unsigned*)((const char*)(gbase) + (voff)[_i]), (PG8_LAS unsigned*)(lds + (bufoff) + ldsw + _i * 8192), 16, 0, 0); } while (0)
#define PG8_LDA(dst, b, h) do { _Pragma("unroll") for (int m = 0; m < 4; ++m) _Pragma("unroll") for (int k = 0; k < 2; ++k) dst[m][k] = *(const PG8_LAS bf16x8*)(lds + PG8_SA(b, h) + aoff + m * 2048 + k * 1024); } while (0)
#define PG8_LDB(dst, b, h) do { _Pragma("unroll") for (int n = 0; n < 2; ++n) _Pragma("unroll") for (int k = 0; k < 2; ++k) dst[n][k] = *(const PG8_LAS bf16x8*)(lds + PG8_SB(b, h) + boff + n * 2048 + k * 1024); } while (0)
#define PG8_MMA(ai, bj, At, Bt) do { __builtin_amdgcn_s_setprio(1); _Pragma("unroll") for (int m = 0; m < 4; ++m) _Pragma("unroll") for (int n = 0; n < 2; ++n) _Pragma("unroll") for (int k = 0; k < 2; ++k) \
        acc[ai][bj][m][n] = __builtin_amdgcn_mfma_f32_16x16x32_bf16(Bt[n][k], At[m][k], acc[ai][bj][m][n], 0, 0, 0); __builtin_amdgcn_s_setprio(0); } while (0)
#define PG8_WAIT_V(n) asm volatile("s_waitcnt vmcnt(" #n ")" ::: "memory")
#define PG8_WAIT_L(n) asm volatile("s_waitcnt lgkmcnt(" #n ")" ::: "memory")
#define PG8_BAR __builtin_amdgcn_s_barrier()
#define PG8_SCHED __builtin_amdgcn_sched_barrier(0)
    Unit cur, nxt; int ui = 0;
    if (!S.next(0, cur)) return;
    f32x4 acc[2][2][4][2];
#pragma unroll
    for (int a = 0; a < 2; ++a)
#pragma unroll
        for (int b = 0; b < 2; ++b)
#pragma unroll
            for (int m = 0; m < 4; ++m)
#pragma unroll
                for (int n = 0; n < 2; ++n) acc[a][b][m][n] = (f32x4){0.f, 0.f, 0.f, 0.f};
    bf16x8 At[4][2], B0[2][2], B1[2][2];
    const char* cA = (const char*)g.A + (size_t)cur.pm * tstep; const char* cB = (const char*)g.Bt + (size_t)cur.pn * tstep;
    S.a_ready(cur);
    if constexpr (SP2) {
        PG8_STAGE(PG8_SB(0, 0), cB, voffB); PG8_STAGE(PG8_SB(0, 1), cB + hstep, voffB); PG8_STAGE(PG8_SA(0, 0), cA, voffA); PG8_STAGE(PG8_SA(0, 1), cA + hstep, voffA);
        if (wr == 1) PG8_BAR;
        PG8_WAIT_V(2); PG8_BAR;
        PG8_STAGE(PG8_SB(1, 0), cB + kstep, voffB); PG8_STAGE(PG8_SA(1, 0), cA + kstep, voffA); PG8_STAGE(PG8_SB(1, 1), cB + hstep + kstep, voffB);
        PG8_WAIT_V(6); PG8_BAR;
    } else {
        PG8_STAGE(PG8_SB(0, 0), cB, voffB); PG8_STAGE(PG8_SA(0, 0), cA, voffA); PG8_STAGE(PG8_SB(0, 1), cB + hstep, voffB); PG8_STAGE(PG8_SA(0, 1), cA + hstep, voffA);
        if (wr == 1) PG8_BAR;
        PG8_WAIT_V(4); PG8_BAR;
        PG8_STAGE(PG8_SB(1, 0), cB + kstep, voffB); PG8_STAGE(PG8_SA(1, 0), cA + kstep, voffA); PG8_STAGE(PG8_SB(1, 1), cB + hstep + kstep, voffB);
        PG8_WAIT_V(6); PG8_BAR;
    }
    for (;;) {
        const bool has_next = S.next(ui + 1, nxt);
        const char* nA = has_next ? (const char*)g.A + (size_t)nxt.pm * tstep : cA; const char* nB = has_next ? (const char*)g.Bt + (size_t)nxt.pn * tstep : cB;
        for (int t = 0; t < nt; t += 2) {
            const bool last = (t == nt - 2);
            const char* a1 = cA + (size_t)(t + 1) * kstep;
            const char* a2 = last ? nA : cA + (size_t)(t + 2) * kstep; const char* b2 = last ? nB : cB + (size_t)(t + 2) * kstep;
            const char* a3 = a2 + kstep; const char* b3 = b2 + kstep;
            if (last && has_next) S.a_ready(nxt);
            if constexpr (SP2) {
            PG8_LDB(B0, 0, 0); PG8_LDB(B1, 0, 1); PG8_SCHED; PG8_LDA(At, 0, 0); PG8_STAGE(PG8_SA(1, 1), a1 + hstep, voffA);
            PG8_WAIT_V(8); PG8_WAIT_L(0); PG8_BAR; PG8_MMA(0, 0, At, B0); PG8_MMA(0, 1, At, B1); PG8_BAR; PG8_SCHED;
            PG8_LDA(At, 0, 1); PG8_STAGE(PG8_SB(0, 0), b2, voffB); PG8_STAGE(PG8_SB(0, 1), b2 + hstep, voffB); PG8_STAGE(PG8_SA(0, 0), a2, voffA);
            PG8_WAIT_V(8); PG8_WAIT_L(0); PG8_BAR; PG8_MMA(1, 0, At, B0); PG8_MMA(1, 1, At, B1); PG8_BAR; PG8_SCHED;
            PG8_LDB(B0, 1, 0); PG8_LDB(B1, 1, 1); PG8_SCHED; PG8_LDA(At, 1, 0); PG8_STAGE(PG8_SA(0, 1), a2 + hstep, voffA);
            PG8_WAIT_V(8); PG8_WAIT_L(0); PG8_BAR; PG8_MMA(0, 0, At, B0); PG8_MMA(0, 1, At, B1); PG8_BAR; PG8_SCHED;
            PG8_LDA(At, 1, 1); PG8_STAGE(PG8_SB(1, 0), b3, voffB); PG8_STAGE(PG8_SB(1, 1), b3 + hstep, voffB); PG8_STAGE(PG8_SA(1, 0), a3, voffA);
            PG8_WAIT_V(8); PG8_WAIT_L(0); PG8_BAR; PG8_MMA(1, 0, At, B0); PG8_MMA(1, 1, At, B1); PG8_BAR; PG8_SCHED;
            } else {
            PG8_LDB(B0, 0, 0); PG8_SCHED; PG8_LDA(At, 0, 0); PG8_STAGE(PG8_SA(1, 1), a1 + hstep, voffA);
            PG8_WAIT_L(8); PG8_BAR; PG8_WAIT_L(0); PG8_MMA(0, 0, At, B0); PG8_BAR; PG8_SCHED;
            PG8_LDB(B1, 0, 1); PG8_STAGE(PG8_SB(0, 0), b2, voffB);
            PG8_BAR; PG8_WAIT_L(0); PG8_MMA(0, 1, At, B1); PG8_BAR;
            PG8_LDA(At, 0, 1); PG8_STAGE(PG8_SA(0, 0), a2, voffA);
            PG8_BAR; PG8_WAIT_L(0); PG8_MMA(1, 0, At, B0); PG8_BAR; PG8_SCHED;
            PG8_STAGE(PG8_SB(0, 1), b2 + hstep, voffB);
            PG8_WAIT_V(6); PG8_BAR; PG8_MMA(1, 1, At, B1); PG8_BAR;
            PG8_LDB(B0, 1, 0); PG8_SCHED; PG8_LDA(At, 1, 0); PG8_STAGE(PG8_SA(0, 1), a2 + hstep, voffA);
            PG8_WAIT_L(8); PG8_BAR; PG8_WAIT_L(0); PG8_MMA(0, 0, At, B0); PG8_BAR; PG8_SCHED;
            PG8_LDB(B1, 1, 1); PG8_STAGE(PG8_SB(1, 0), b3, voffB);
            PG8_BAR; PG8_WAIT_L(0); PG8_MMA(0, 1, At, B1); PG8_BAR;
            PG8_LDA(At, 1, 1); PG8_STAGE(PG8_SA(1, 0), a3, voffA);
            PG8_BAR; PG8_WAIT_L(0); PG8_MMA(1, 0, At, B0); PG8_BAR; PG8_SCHED;
            PG8_STAGE(PG8_SB(1, 1), b3 + hstep, voffB);
            PG8_WAIT_V(6); PG8_BAR; PG8_MMA(1, 1, At, B1); PG8_BAR;
            }
        }
        if constexpr (ALIGN_EPI) { if (wr == 0) PG8_BAR; }
        if constexpr (!Epi::AFTER_DRAIN) { E(acc, cur, wr, wc, fr, fq); S.done(cur); }
        if (!has_next) break;
#pragma unroll
        for (int a = 0; a < 2; ++a)
#pragma unroll
            for (int b = 0; b < 2; ++b)
#pragma unroll
                for (int m = 0; m < 4; ++m)
#pragma unroll
                    for (int n = 0; n < 2; ++n) acc[a][b][m][n] = (f32x4){0.f, 0.f, 0.f, 0.f};
        cur = nxt; cA = nA; cB = nB; ++ui;
        if constexpr (ALIGN_EPI) { if (wr == 1) PG8_BAR; }
    }
    PG8_WAIT_V(0);
    if constexpr (!ALIGN_EPI) { if (wr == 0) PG8_BAR; }
    PG8_BAR;
    if constexpr (Epi::AFTER_DRAIN) { E.fused(acc, cur, wr, wc, fr, fq, lds, wid, lane); S.done(cur); }
#undef PG8_SA
#undef PG8_SB
#undef PG8_STAGE
#undef PG8_LDA
#undef PG8_LDB
#undef PG8_MMA
#undef PG8_WAIT_V
#undef PG8_WAIT_L
#undef PG8_BAR
#undef PG8_SCHED
}
}
namespace attn_body {
using bf16=__hip_bfloat16;
using bf16x8=__attribute__((ext_vector_type(8)))short;
using s16x4=__attribute__((ext_vector_type(4)))short;
using f32x16=__attribute__((ext_vector_type(16)))float;
using u32x4=__attribute__((ext_vector_type(4)))unsigned;
constexpr int BATCH=4,NHEAD=8,SEQ=4096,D=64,DM=NHEAD*D,OP=1024;
constexpr int NW=8,QBLK=32,QB=QBLK*NW,KVBLK=64,NQB=SEQ/QB;
constexpr int ATTN_PITCH=DM, ATTN_UNIT_ROWS=QB;
__device__ __forceinline__ int crow(int r,int hi){return (r&3)+8*(r>>2)+4*hi;}
#define SBAR() __builtin_amdgcn_sched_barrier(0)
__device__ __forceinline__ void cmask(f32x16&p0,f32x16&p1,int jb,int qrel,int hi){
  const float NEG=-INFINITY; int kb=64*jb+4*hi;
  #pragma unroll
  for(int r=0;r<16;++r){int kv=kb+(r&3)+8*(r>>2); if(kv>qrel)p0[r]=NEG; if(kv+32>qrel)p1[r]=NEG;}
}

constexpr int NSLOT=3, SLOTB=8192;
constexpr int LDS_K=0, LDS_V=NSLOT*SLOTB, LDS_WS=2*NSLOT*SLOTB, LDS_OST=LDS_WS+NW*64*4, LDS_BYTES=LDS_OST+NW*4096;
constexpr float C2=0.125f*1.4426950408889634f;
__device__ __forceinline__ void glds16(const void*gsrc,unsigned lds_dst){unsigned keep;
  asm volatile("s_mov_b32 %0, m0\n\ts_mov_b32 m0, %2\n\ts_nop 0\n\tglobal_load_lds_dwordx4 %1, off\n\ts_mov_b32 m0, %0":"=&s"(keep):"v"(gsrc),"s"(lds_dst):"memory");}
__device__ __forceinline__ float max3f(float a,float b,float c){float r;asm("v_max3_f32 %0, %1, %2, %3":"=v"(r):"v"(a),"v"(b),"v"(c));return r;}
__device__ __forceinline__ float max2f(float a,float b){float r;asm("v_max_f32_e32 %0, %1, %2":"=v"(r):"v"(a),"v"(b));return r;}
__device__ __forceinline__ float fadd_s(float a,float b){float r;asm("v_add_f32_e32 %0, %1, %2":"=v"(r):"v"(a),"v"(b));return r;}
__device__ __forceinline__ float fsub_s(float a,float b){float r;asm("v_sub_f32_e32 %0, %1, %2":"=v"(r):"v"(a),"v"(b));return r;}
typedef float f32x2_t __attribute__((ext_vector_type(2))); typedef __bf16 bf16x2_t __attribute__((ext_vector_type(2)));
__device__ __forceinline__ unsigned cvtpk_s(float lo,float hi){f32x2_t v={lo,hi};bf16x2_t b=__builtin_convertvector(v,bf16x2_t);return __builtin_bit_cast(unsigned,b);}
#define WAIT_BAR(N) asm volatile("s_waitcnt vmcnt(" #N ") lgkmcnt(0)\n\ts_barrier":::"memory")

__device__ __forceinline__ void qkt(f32x16&p0,f32x16&p1,const char*Kslot,const bf16x8*qr,int r32,int hi){ const f32x16 zc=f32x16{};
  const char*kb=Kslot+hi*1024+r32*16;
  #pragma unroll
  for(int d0=0;d0<4;++d0){
    const bf16x8 b0=*reinterpret_cast<const bf16x8*>(kb+d0*2048);
    const bf16x8 b1=*reinterpret_cast<const bf16x8*>(kb+d0*2048+512);
    if(d0==0){p0=__builtin_amdgcn_mfma_f32_32x32x16_bf16(b0,qr[0],zc,0,0,0);p1=__builtin_amdgcn_mfma_f32_32x32x16_bf16(b1,qr[0],zc,0,0,0);}
    else{p0=__builtin_amdgcn_mfma_f32_32x32x16_bf16(b0,qr[d0],p0,0,0,0);p1=__builtin_amdgcn_mfma_f32_32x32x16_bf16(b1,qr[d0],p1,0,0,0);}}
}
typedef __attribute__((address_space(3))) const char* lds_cptr;
typedef short v4i16_t __attribute__((ext_vector_type(4)));
__device__ __forceinline__ void kload8(bf16x8*kf,lds_cptr kp){
  kf[0]=*(const __attribute__((address_space(3))) bf16x8*)(kp);      kf[1]=*(const __attribute__((address_space(3))) bf16x8*)(kp+512);
  kf[2]=*(const __attribute__((address_space(3))) bf16x8*)(kp+2048); kf[3]=*(const __attribute__((address_space(3))) bf16x8*)(kp+2560);
  kf[4]=*(const __attribute__((address_space(3))) bf16x8*)(kp+4096); kf[5]=*(const __attribute__((address_space(3))) bf16x8*)(kp+4608);
  kf[6]=*(const __attribute__((address_space(3))) bf16x8*)(kp+6144); kf[7]=*(const __attribute__((address_space(3))) bf16x8*)(kp+6656);
}
__device__ __forceinline__ void kload2(bf16x8*kf,lds_cptr kp,int j){ kf[2*j]=*(const __attribute__((address_space(3))) bf16x8*)(kp+j*2048); kf[2*j+1]=*(const __attribute__((address_space(3))) bf16x8*)(kp+j*2048+512); }
__device__ __forceinline__ s16x4 vtr(lds_cptr p){ return __builtin_bit_cast(s16x4,__builtin_amdgcn_ds_read_tr16_b64_v4i16((__attribute__((address_space(3))) v4i16_t*)p)); }
__device__ __forceinline__ float rowmax(const f32x16&p0,const f32x16&p1){
  float a=max3f(p0[0],p0[1],p1[0]),b=max3f(p0[2],p0[3],p1[1]);a=max3f(a,p1[2],p1[3]);
  #pragma unroll
  for(int r=4;r<16;r+=4){a=max3f(a,p0[r],p0[r+1]);b=max3f(b,p0[r+2],p0[r+3]);a=max3f(a,p1[r],p1[r+1]);b=max3f(b,p1[r+2],p1[r+3]);}
  const float m=max2f(a,b);
  auto rr=__builtin_amdgcn_permlane32_swap(__float_as_uint(m),__float_as_uint(m),false,false);
  return max2f(__uint_as_float(rr[0]),__uint_as_float(rr[1]));
}
__device__ __forceinline__ void pv(f32x16*o,int vb,bf16x8 pa0,bf16x8 pa1,bf16x8 pa2,bf16x8 pa3){
  #pragma unroll
  for(int d0=0;d0<2;++d0){s16x4 lo[4],hi[4];
    #pragma unroll
    for(int ks=0;ks<4;++ks){
      asm volatile("ds_read_b64_tr_b16 %0,%1 offset:%c2":"=&v"(lo[ks]):"v"(vb),"i"(d0*4096+ks*1024):"memory");
      asm volatile("ds_read_b64_tr_b16 %0,%1 offset:%c2":"=&v"(hi[ks]):"v"(vb),"i"(d0*4096+ks*1024+512):"memory");}
    asm volatile("s_waitcnt lgkmcnt(0)":::"memory");SBAR();
    #define PK(k) (bf16x8){lo[k][0],lo[k][1],lo[k][2],lo[k][3],hi[k][0],hi[k][1],hi[k][2],hi[k][3]}
    o[d0]=__builtin_amdgcn_mfma_f32_32x32x16_bf16(pa0,PK(0),o[d0],0,0,0);
    o[d0]=__builtin_amdgcn_mfma_f32_32x32x16_bf16(pa1,PK(1),o[d0],0,0,0);
    o[d0]=__builtin_amdgcn_mfma_f32_32x32x16_bf16(pa2,PK(2),o[d0],0,0,0);
    o[d0]=__builtin_amdgcn_mfma_f32_32x32x16_bf16(pa3,PK(3),o[d0],0,0,0);
    #undef PK
  }
}

#ifndef ATTN_STORE16
#define ATTN_STORE16(p,v) (*(u32x4*)(p)=(v))
#endif
template<int THRL> __device__ __forceinline__ void attn_unit(int b,int h,int qb,const bf16*Q,const bf16*__restrict__ K,const bf16*__restrict__ V,bf16*O,const bf16*__restrict__ KM,char*shm){
  const int tid=threadIdx.x,lane=tid&63,r32=lane&31,hi=lane>>5; const int wid=__builtin_amdgcn_readfirstlane(tid>>6);
  const long rowbase=(long)b*SEQ; const int q0=qb*QB;
  const bf16*Qw=Q+(rowbase+q0+wid*QBLK)*DM+h*D;
  const bf16*Kh=K+rowbase*DM+h*D,*Vh=V+rowbase*DM+h*D;
  const unsigned lds0=(unsigned)(uintptr_t)shm;
  float*wsf=(float*)(shm+LDS_WS)+wid*64;
  const bf16*ksrc=Kh+(long)lane*DM+wid*8;
  const bf16*vsrc=Vh+(long)(16*(wid&3)+(lane>>2))*DM+(wid>>2)*32+(lane&3)*8;
  const unsigned kdst=lds0+LDS_K+wid*1024, vdst=lds0+LDS_V+wid*1024;
  #define DMA_K(t,slot) glds16(ksrc+(long)(t)*KVBLK*DM,(unsigned)__builtin_amdgcn_readfirstlane(kdst+(slot)))
  #define DMA_V(t,slot) glds16(vsrc+(long)(t)*KVBLK*DM,(unsigned)__builtin_amdgcn_readfirstlane(vdst+(slot)))
  const int vb0=(int)(lds0+LDS_V)+((lane>>4)&1)*32+(lane&3)*8+(4*hi+((lane&15)>>2))*64;
  const char*Kbase=shm+LDS_K; bf16x8 kf[8];
  const lds_cptr shm3=(lds_cptr)shm; const lds_cptr kp0=shm3+LDS_K+hi*1024+r32*16; const lds_cptr vp0=shm3+LDS_V+((lane>>4)&1)*32+(lane&3)*8+(4*hi+((lane&15)>>2))*64;
  const int NT=(q0+QB)/KVBLK;
  bf16x8 qr[4];
  #pragma unroll
  for(int d0=0;d0<4;++d0)qr[d0]=*reinterpret_cast<const bf16x8*>(&Qw[(long)r32*DM+d0*16+hi*8]);
  unsigned sel=(1u<<qb)-1u;
  if(qb>3){
    glds16(KM+((long)(b*NHEAD+h)*64+lane)*64+wid*8,(unsigned)__builtin_amdgcn_readfirstlane(kdst));
    WAIT_BAR(0);
    f32x16 g=f32x16{};
    { const char*kb=shm+LDS_K+hi*1024+r32*16;
      #pragma unroll
      for(int d0=0;d0<4;++d0){const bf16x8 b0=*reinterpret_cast<const bf16x8*>(kb+d0*2048); g=__builtin_amdgcn_mfma_f32_32x32x16_bf16(b0,qr[d0],g,0,0,0);} }
    float gv[16];
    #pragma unroll
    for(int r=0;r<8;++r){const float mine=g[r]; const float oth=__shfl_xor(mine,32);
      const int jlo=(r&3)+8*(r>>2), jhi=jlo+4; gv[jlo]=hi?oth:mine; gv[jhi]=hi?mine:oth; }
    #pragma unroll
    for(int j=0;j<16;++j) if(j>=qb) gv[j]=-INFINITY;
    sel=0u;
    #pragma unroll
    for(int k=0;k<3;++k){ float bv=gv[0]; int bi=0;
      #pragma unroll
      for(int j=1;j<16;++j){ if(gv[j]>bv){bv=gv[j];bi=j;} }
      sel|=1u<<bi;
      #pragma unroll
      for(int j=0;j<16;++j) gv[j]=(j==bi)?-INFINITY:gv[j]; }
    asm volatile("s_waitcnt lgkmcnt(0)\n\ts_barrier":::"memory");
  }
  DMA_K(0,0);DMA_V(0,0);DMA_K(1,SLOTB);
  float mhat=0.f,l_reg=0.f;f32x16 o[2];o[0]=f32x16{};o[1]=f32x16{};const f32x16 zc=f32x16{};
  const int qrel=wid*QBLK+r32;
  #define BMASK(P0,P1,t) do{ if(!((sel>>((t)>>2))&1u)){ _Pragma("unroll") for(int r_=0;r_<16;++r_){P0[r_]=-INFINITY;P1[r_]=-INFINITY;} } }while(0)
  #define CMASK(P0,P1,t) do{int jb_=(t)-(NT-4); if(jb_>=0)cmask(P0,P1,jb_,qrel,hi); else BMASK(P0,P1,t);}while(0)
  bool resc=false;
  #define START(P0,P1) do{ const float rm=rowmax(P0,P1); resc=false; \
    if(__any(rm>(float)THRL)){ const float dl=__builtin_fmaxf(rm,0.f); mhat=fadd_s(mhat,dl); } \
    _Pragma("unroll") for(int r=0;r<16;++r)P0[r]=__builtin_amdgcn_exp2f(P0[r]-mhat); }while(0)
  #define RESC() do{ if(resc){ asm volatile("s_waitcnt lgkmcnt(0)":::"memory"); \
      _Pragma("unroll") for(int d_=0;d_<2;++d_) _Pragma("unroll") for(int r=0;r<16;++r)o[d_][r]*=wsf[crow(r,hi)]; } }while(0)
  f32x16 pA0,pA1,pB0,pB1;
  int sl_prev=0,sl_cur=0,sl_next=SLOTB;
  #define ROT() do{sl_prev=sl_cur;sl_cur=sl_next;sl_next=(sl_next==(NSLOT-1)*SLOTB)?0:sl_next+SLOTB;}while(0)
  DMA_K(2,2*SLOTB);
  WAIT_BAR(3);
  qkt(pA0,pA1,Kbase,qr,r32,hi);asm volatile("s_nop 15\n\ts_nop 7":"+v"(pA0),"+v"(pA1));CMASK(pA0,pA1,0);
  START(pA0,pA1);
  _Pragma("unroll") for(int r=0;r<16;++r)pA1[r]=__builtin_amdgcn_exp2f(pA1[r]-mhat);
  WAIT_BAR(0);
  DMA_K(3,0);DMA_V(1,SLOTB);
  ROT();
  kload8(kf,kp0+sl_cur);
  WAIT_BAR(2);
  s16x4 vlo[8],vhi[8]; u32x4 pw0,pw1,pw2,pw3;
  #define PKW(P,B) cvtpk_s(P[B],P[B+1])
  #define PAF(k) __builtin_bit_cast(bf16x8,pw##k)
  #define VFR(i) (bf16x8){vlo[i][0],vlo[i][1],vlo[i][2],vlo[i][3],vhi[i][0],vhi[i][1],vhi[i][2],vhi[i][3]}
  #define PIN(x) asm volatile("":"+v"(x))
  #define MX3(a,b,c) __builtin_fmaxf(__builtin_fmaxf((a),(b)),(c))
  #define GAPA(MF,A0,A1,A2,A3,W0,W1,PW) do{ MF; sacc+=A0; sacc+=A1; sacc+=A2; sacc+=A3; PIN(sacc); W0; W1; PIN(PW); SBAR(); }while(0)
  #define EX(v) __builtin_amdgcn_exp2f(v)
  #define GAPB(MF,X,B) do{ MF; X[B]=EX(X[B]-mhat); X[B+1]=EX(X[B+1]-mhat); X[B+2]=EX(X[B+2]-mhat); X[B+3]=EX(X[B+3]-mhat); PIN(X); SBAR(); }while(0)
  #define VRD(i) do{ vlo[i]=vtr(vp_+(((i)>>2)*4096+((i)&3)*1024)); vhi[i]=vtr(vp_+(((i)>>2)*4096+((i)&3)*1024+512)); }while(0)
  #define KRD(G,j) do{ if(G){ kload2(kf,kp0+sl_next,j); SBAR(); } }while(0)
  #define STEP(C0,C1,P0,P1,t,GK,GV,GL) do{ SBAR(); \
    const lds_cptr vp_=vp0+sl_prev; \
    VRD(0); SBAR(); float sacc=(P0[0]+P0[1]); \
    GAPA(C0=__builtin_amdgcn_mfma_f32_32x32x16_bf16(kf[0],qr[0],zc,0,0,0), P0[2],P0[3],P0[4],P0[5],     pw0[0]=PKW(P0,0), pw0[1]=PKW(P0,2), pw0); \
    VRD(4); SBAR(); GAPA(C1=__builtin_amdgcn_mfma_f32_32x32x16_bf16(kf[1],qr[0],zc,0,0,0), P0[6],P0[7],P0[8],P0[9],     pw0[2]=PKW(P0,4), pw0[3]=PKW(P0,6), pw0); \
    VRD(1); SBAR(); GAPA(C0=__builtin_amdgcn_mfma_f32_32x32x16_bf16(kf[2],qr[1],C0,0,0,0),   P0[10],P0[11],P0[12],P0[13], pw1[0]=PKW(P0,8), pw1[1]=PKW(P0,10), pw1); \
    VRD(5); SBAR(); GAPA(C1=__builtin_amdgcn_mfma_f32_32x32x16_bf16(kf[3],qr[1],C1,0,0,0),   P0[14],P0[15],P1[0],P1[1],   pw1[2]=PKW(P0,12),pw1[3]=PKW(P0,14), pw1); \
    VRD(2); SBAR(); GAPA(C0=__builtin_amdgcn_mfma_f32_32x32x16_bf16(kf[4],qr[2],C0,0,0,0),   P1[2],P1[3],P1[4],P1[5],     pw2[0]=PKW(P1,0), pw2[1]=PKW(P1,2), pw2); \
    VRD(6); SBAR(); GAPA(C1=__builtin_amdgcn_mfma_f32_32x32x16_bf16(kf[5],qr[2],C1,0,0,0),   P1[6],P1[7],P1[8],P1[9],     pw2[2]=PKW(P1,4), pw2[3]=PKW(P1,6), pw2); \
    VRD(3); SBAR(); GAPA(C0=__builtin_amdgcn_mfma_f32_32x32x16_bf16(kf[6],qr[3],C0,0,0,0),   P1[10],P1[11],P1[12],P1[13], pw3[0]=PKW(P1,8), pw3[1]=PKW(P1,10), pw3); \
    VRD(7); SBAR(); GAPA(C1=__builtin_amdgcn_mfma_f32_32x32x16_bf16(kf[7],qr[3],C1,0,0,0),   P1[14],P1[15],0.f,0.f,       pw3[2]=PKW(P1,12),pw3[3]=PKW(P1,14), pw3); \
    l_reg+=sacc; \
    if(GK){DMA_K((t)+3,sl_cur);} if(GV){DMA_V((t)+1,sl_next);} \
    CMASK(C0,C1,t); \
    { float a=MX3(C0[0],C0[1],C1[0]),b=MX3(C0[2],C0[3],C1[1]); a=MX3(a,C1[2],C1[3]); \
      _Pragma("unroll") for(int r=4;r<16;r+=4){a=MX3(a,C0[r],C0[r+1]);b=MX3(b,C0[r+2],C0[r+3]);a=MX3(a,C1[r],C1[r+1]);b=MX3(b,C1[r+2],C1[r+3]);} \
      float rm=__builtin_fmaxf(a,b); { auto rr=__builtin_amdgcn_permlane32_swap(__float_as_uint(rm),__float_as_uint(rm),false,false); rm=__builtin_fmaxf(__uint_as_float(rr[0]),__uint_as_float(rr[1])); } \
      resc=false; \
      if(__builtin_expect(__any(rm-mhat>(float)THRL),0)){ const float dl=__builtin_fmaxf(rm-mhat,0.f); mhat+=dl; \
        const float f=__builtin_amdgcn_exp2f(-dl); l_reg*=f; if(hi==0)wsf[r32]=f; resc=true; } } \
    SBAR(); \
    GAPB(o[0]=__builtin_amdgcn_mfma_f32_32x32x16_bf16(PAF(0),VFR(0),o[0],0,0,0), C0,0); \
    GAPB(o[1]=__builtin_amdgcn_mfma_f32_32x32x16_bf16(PAF(0),VFR(4),o[1],0,0,0), C0,4); \
    KRD(GL,0); GAPB(o[0]=__builtin_amdgcn_mfma_f32_32x32x16_bf16(PAF(1),VFR(1),o[0],0,0,0), C0,8); \
    KRD(GL,1); GAPB(o[1]=__builtin_amdgcn_mfma_f32_32x32x16_bf16(PAF(1),VFR(5),o[1],0,0,0), C0,12); \
    KRD(GL,2); GAPB(o[0]=__builtin_amdgcn_mfma_f32_32x32x16_bf16(PAF(2),VFR(2),o[0],0,0,0), C1,0); \
    KRD(GL,3); GAPB(o[1]=__builtin_amdgcn_mfma_f32_32x32x16_bf16(PAF(2),VFR(6),o[1],0,0,0), C1,4); \
    GAPB(o[0]=__builtin_amdgcn_mfma_f32_32x32x16_bf16(PAF(3),VFR(3),o[0],0,0,0), C1,8); \
    GAPB(o[1]=__builtin_amdgcn_mfma_f32_32x32x16_bf16(PAF(3),VFR(7),o[1],0,0,0), C1,12); \
    }while(0)
  int t=1;
  #undef CMASK
  #define CMASK(P0,P1,t) BMASK(P0,P1,t)
  for(;t+5<NT;t+=2){
    STEP(pB0,pB1,pA0,pA1,t,true,true,true);     WAIT_BAR(2); RESC(); ROT();
    STEP(pA0,pA1,pB0,pB1,t+1,true,true,true);   WAIT_BAR(2); RESC(); ROT();
  }
  #undef CMASK
  #define CMASK(P0,P1,t) do{int jb_=(t)-(NT-4); if(jb_>=0)cmask(P0,P1,jb_,qrel,hi); else BMASK(P0,P1,t);}while(0)
  #define ENDW(tt) do{ if((tt)+3<NT){WAIT_BAR(2);} else if((tt)+2<NT){WAIT_BAR(1);} else {WAIT_BAR(0);} }while(0)
  for(;t+1<NT;t+=2){
    STEP(pB0,pB1,pA0,pA1,t,(t+3<NT),(t+1<NT),(t+1<NT));       ENDW(t);   RESC(); ROT();
    STEP(pA0,pA1,pB0,pB1,t+1,(t+4<NT),(t+2<NT),(t+2<NT));     ENDW(t+1); RESC(); ROT();
  }
  STEP(pB0,pB1,pA0,pA1,NT-1,false,false,false); RESC();
  { float sacc=pB0[0]+pB0[1]; _Pragma("unroll") for(int r=2;r<16;++r)sacc+=pB0[r]; _Pragma("unroll") for(int r=0;r<16;++r)sacc+=pB1[r]; l_reg+=sacc;
    pw0=(u32x4){PKW(pB0,0),PKW(pB0,2),PKW(pB0,4),PKW(pB0,6)};pw1=(u32x4){PKW(pB0,8),PKW(pB0,10),PKW(pB0,12),PKW(pB0,14)};pw2=(u32x4){PKW(pB1,0),PKW(pB1,2),PKW(pB1,4),PKW(pB1,6)};pw3=(u32x4){PKW(pB1,8),PKW(pB1,10),PKW(pB1,12),PKW(pB1,14)};
    SBAR(); pv(o,vb0+sl_cur,PAF(0),PAF(1),PAF(2),PAF(3)); }
  #undef PKW
  #undef PAF
  #undef VFR
  #undef PIN
  #undef MX3
  #undef GAPA
  #undef GAPB
  #undef EX
  #undef VRD
  #undef KRD
  #undef STEP
  #undef ENDW
  {auto rr=__builtin_amdgcn_permlane32_swap(__float_as_uint(l_reg),__float_as_uint(l_reg),false,false);l_reg=__uint_as_float(rr[0])+__uint_as_float(rr[1]);}
  if(hi==0)wsf[32+r32]=l_reg;asm volatile("s_waitcnt lgkmcnt(0)":::"memory");
  float rli[16];
  #pragma unroll
  for(int r=0;r<16;++r)rli[r]=__builtin_amdgcn_rcpf(wsf[32+crow(r,hi)]);
  bf16*Ow=O+(rowbase+q0+wid*QBLK)*OP+h*D;
  { bf16*stg=(bf16*)(shm+LDS_OST)+wid*2048;
    #pragma unroll
    for(int r=0;r<16;++r){const int orow=crow(r,hi);
      #pragma unroll
      for(int d0=0;d0<2;++d0)stg[orow*64+d0*32+r32]=__float2bfloat16(o[d0][r]*rli[r]);}
    asm volatile("s_waitcnt lgkmcnt(0)":::"memory");
    #pragma unroll
    for(int i=0;i<4;++i){const int row=i*8+(lane>>3),ch=lane&7; const u32x4 v=*(const u32x4*)(stg+row*64+ch*8); ATTN_STORE16(Ow+(long)row*OP+ch*8,v);} }
  asm volatile("s_waitcnt lgkmcnt(0)\n\ts_barrier":::"memory");
  #undef DMA_K
  #undef DMA_V
  #undef CMASK
  #undef BMASK
  #undef START
  #undef RESC
  #undef ROT
}
constexpr int ATTN_LDS_BYTES=LDS_BYTES;
#undef SBAR
#undef WAIT_BAR
}

constexpr int NWAVES = 8, NTHR = NWAVES * 64;
constexpr int DMODEL = 1024, PB = 4, PS = 4096, MP = PB * PS  , SB = 32  , MPAD = 16640  ;
constexpr int NIN = 3592, NZ = 3584, FF = 4096, AH = 8, AD = 64, MH = 4, MD = 128, NCH = 64  , CH = 64, NPAGES = 64;
constexpr float RMS_EPS = 1e-6f;
constexpr float QK_SCALE_M = 0.08838834764831845f;
constexpr int N_PHASES = 9;
#ifndef MK_PER_PHASE
#define MK_PER_PHASE 0
#endif

constexpr size_t O_Y = 0, O_YS = 16777216, O_KP = 16809984, O_VP = 25198592, O_CP = 33587200, O_NP = 33849344, O_MPR = 33851392, O_KS = 33851408, O_VS = 33867792,
                 O_CS = 33884176, O_NS = 35981328, O_MS = 35997712, O_END = 35997840;

constexpr size_t MiB = 1u << 20;
constexpr size_t WS_CTL = 0, CTL_ZERO_BYTES = 1 * MiB;
constexpr size_t WS_KMP = 256 * 1024;
constexpr size_t WS_WIN = 2 * MiB, WS_WOUT = 10 * MiB, WS_WUP = 12 * MiB, WS_WDN = 20 * MiB;
constexpr size_t WS_GATES = 28 * MiB;
constexpr size_t WS_SSQ1 = 29 * MiB, WS_SSQ2 = 30 * MiB;
constexpr size_t WS_SMALL = 31 * MiB;
constexpr size_t SM_AB = 0;
constexpr size_t SM_MC = 16384;
constexpr size_t SM_DN = 32768;
constexpr size_t SM_NC = SM_DN + 524288;
constexpr size_t SM_KMB = SM_NC + 524288;
constexpr size_t SM_X1S = SM_KMB + 262144;
constexpr size_t SM_X2S = SM_X1S + 131072;
constexpr size_t SM_X1SB = SM_X2S + 131072;
constexpr size_t SM_US = SM_X1SB + 65536;
constexpr size_t SM_END = SM_US + 262144;
static_assert(SM_END <= 3 * MiB, "small tables");
constexpr size_t WS_KMS = 34 * MiB;
constexpr size_t WS_XN = 36 * MiB;
constexpr size_t WS_Z = 70 * MiB, Z_STRIDE_B = 17 * MiB;
constexpr size_t WS_MIX = 190 * MiB;
constexpr size_t WS_X1 = 224 * MiB;
constexpr size_t WS_X1B = 288 * MiB;
constexpr size_t WS_U = 320 * MiB;
constexpr size_t WS_DCT = 448 * MiB;
constexpr size_t WS_CT = 480 * MiB;
constexpr size_t WS_END = 512 * MiB;
static_assert(WS_WIN + (size_t)NZ * DMODEL * 2 <= WS_WOUT && WS_XN + (size_t)MPAD * DMODEL * 2 <= WS_Z && (size_t)MPAD * 512 * 2 <= Z_STRIDE_B && WS_Z + 7 * Z_STRIDE_B <= WS_MIX
              && WS_MIX + (size_t)MPAD * DMODEL * 2 <= WS_X1 && WS_GATES + (size_t)MPAD * 8 * 4 <= WS_SSQ1, "d_ws map");
constexpr int CW_TMO = 0, CW_CODE = 1;
constexpr int CW_BAR = 4096;

constexpr int RING_OFF = 0, RING_BYTES = 131072;
constexpr int LDSCTL_OFF = RING_BYTES, MISC_OFF = LDSCTL_OFF + 320;
constexpr int LDS_BYTES = 147456;
constexpr int ML_K = 0, ML_V = 16384, ML_Q = 32768, ML_C = 49152, ML_S = 81920, ML_SPITCH = 144, ML_VEC = 91136;

#define GAS __attribute__((address_space(1)))
#define LAS __attribute__((address_space(3)))
typedef unsigned short bf16;
typedef unsigned v4u __attribute__((ext_vector_type(4)));
typedef float f32x4 __attribute__((ext_vector_type(4)));
typedef short bf16x8 __attribute__((ext_vector_type(8)));
typedef GAS unsigned gu32;
typedef GAS unsigned long long gu64;
#define RLX_AGENT __ATOMIC_RELAXED, __HIP_MEMORY_SCOPE_AGENT
#define LDS_WAIT() asm volatile("s_waitcnt lgkmcnt(0)" ::: "memory")
#define VM_WAIT() asm volatile("s_waitcnt vmcnt(0)" ::: "memory")
__device__ __forceinline__ unsigned long long rt() { return __builtin_amdgcn_s_memrealtime(); }
__device__ __forceinline__ unsigned f2bf(float f) { unsigned u = __builtin_bit_cast(unsigned, f); return (u + 0x7fffu + ((u >> 16) & 1u)) >> 16; }
__device__ __forceinline__ unsigned pk2(float lo, float hi) { return f2bf(lo) | (f2bf(hi) << 16); }

#define XB_TMO      128
#define XB_XCNT(j)  (256  + 64 * (j))
#define XB_XSUB(j)  (1280 + 64 * (j))
#define XB_XGEN(j)  (2304 + 64 * (j))
#define XB_TOP      3328
#define XB_TOPGEN   3392
#define XCD_BAR_WORDS 3456
#define XB_SPIN_CAP (1u << 18)

__device__ __forceinline__ unsigned xb_ld(unsigned* p)              { return __hip_atomic_load(p, __ATOMIC_RELAXED, __HIP_MEMORY_SCOPE_AGENT); }
__device__ __forceinline__ unsigned xb_add(unsigned* p, unsigned v) { return __hip_atomic_fetch_add(p, v, __ATOMIC_RELAXED, __HIP_MEMORY_SCOPE_AGENT); }
__device__ __forceinline__ unsigned xb_xcc_id() { return (unsigned)__builtin_amdgcn_s_getreg((3 << 11) | 20) & 0xFu; }
#define XB_SPIN(cond, bar) do { unsigned _sp = 0; while (cond) { __builtin_amdgcn_s_sleep(1); \
    if ((++_sp & 255u) == 0u) { if (xb_ld(&(bar)[XB_TMO])) break; if (_sp > XB_SPIN_CAP) { atomicAdd(&(bar)[XB_TMO], 1u); break; } } } } while (0)

struct XcdBarrier {
    unsigned* bar; unsigned x;
    volatile LAS unsigned* st;
};

__device__ __forceinline__ XcdBarrier xcd_barrier_post(unsigned* bar, volatile LAS unsigned* st) {
    XcdBarrier b; b.bar = bar; b.x = xb_xcc_id(); b.st = st;
    if (threadIdx.x == 0) (void)xb_add(&bar[XB_XCNT(b.x)], 1u);
    return b;
}
__device__ __forceinline__ void xcd_barrier_complete(unsigned* bar, unsigned x, unsigned& nloc, unsigned& nx) {
    const unsigned G = gridDim.x * gridDim.y * gridDim.z;
    unsigned sum, cnt, mine, sp = 0u;
    for (;;) {
        sum = 0u; cnt = 0u; mine = 0u;
#pragma unroll
        for (unsigned j = 0; j < 16; ++j) { const unsigned c = xb_ld(&bar[XB_XCNT(j)]); sum += c; cnt += (c > 0u) ? 1u : 0u; mine = (j == x) ? c : mine; }
        if (sum == G) break;
        __builtin_amdgcn_s_sleep(1);
        if ((++sp & 255u) == 0u) { if (xb_ld(&bar[XB_TMO])) break; if (sp > XB_SPIN_CAP) { atomicAdd(&bar[XB_TMO], 1u); break; } }
    }
    nloc = mine > 0u ? mine : 1u; nx = cnt > 0u ? cnt : 1u;
}

__device__ __forceinline__ void xcd_barrier(const XcdBarrier& b) {
    asm volatile("s_waitcnt vmcnt(0)" ::: "memory");
    __syncthreads();
    if (threadIdx.x == 0) {
        unsigned* bar = b.bar;
        __builtin_amdgcn_s_waitcnt(0);
        unsigned nloc = b.st[0], nx = b.st[1];
        if (nloc == 0u) { xcd_barrier_complete(bar, b.x, nloc, nx); b.st[0] = nloc; b.st[1] = nx; }
        const unsigned old = xb_add(&bar[XB_XSUB(b.x)], 1u);
        const unsigned gen = old / nloc;
        if (old + 1u == (gen + 1u) * nloc) {
            __builtin_amdgcn_fence(__ATOMIC_RELEASE, "agent");
            asm volatile("s_waitcnt vmcnt(0)" ::: "memory");
            const unsigned og = xb_add(&bar[XB_TOP], 1u);
            const unsigned tg = og / nx;
            if (og + 1u == (tg + 1u) * nx) xb_add(&bar[XB_TOPGEN], 1u);
            else XB_SPIN(xb_ld(&bar[XB_TOPGEN]) == tg, bar);
            __builtin_amdgcn_fence(__ATOMIC_ACQUIRE, "agent");
            xb_add(&bar[XB_XGEN(b.x)], 1u);
            asm volatile("s_waitcnt vmcnt(0)" ::: "memory");
        } else {
            XB_SPIN(xb_ld(&bar[XB_XGEN(b.x)]) == gen, bar);
            __builtin_amdgcn_fence(__ATOMIC_ACQUIRE, "agent");
            asm volatile("s_waitcnt vmcnt(0)" ::: "memory");
        }
    }
    __syncthreads();
}

typedef float f32x2 __attribute__((ext_vector_type(2)));
typedef unsigned u32x2 __attribute__((ext_vector_type(2)));
typedef short v4i16_t __attribute__((ext_vector_type(4)));
struct Args { const void* in[17]; float* out; unsigned char* ws; int ph_lo, ph_hi; };

__device__ __forceinline__ float bf2f(bf16 v) { return __uint_as_float((unsigned)v << 16); }
__device__ __forceinline__ float bflo(unsigned w) { return __uint_as_float(w << 16); }
__device__ __forceinline__ float bfhi(unsigned w) { return __uint_as_float(w & 0xffff0000u); }
__device__ __forceinline__ float wave_sum(float v) {
#pragma unroll
    for (int o = 1; o < 64; o <<= 1) v += __shfl_xor(v, o);
    return v;
}
__device__ __forceinline__ float wave_max(float v) {
#pragma unroll
    for (int o = 1; o < 64; o <<= 1) v = fmaxf(v, __shfl_xor(v, o));
    return v;
}
__device__ __forceinline__ float log_sigmoid(float x) { return fminf(x, 0.f) - log1pf(expf(-fabsf(x))); }
__device__ __forceinline__ float sigmoidf(float x) { return 1.0f / (1.0f + expf(-x)); }
__device__ __forceinline__ f32x4 mfma16(bf16x8 a, bf16x8 b, f32x4 c) { return __builtin_amdgcn_mfma_f32_16x16x32_bf16(a, b, c, 0, 0, 0); }

__device__ __forceinline__ unsigned off_b(unsigned row, unsigned ch) { return 256u * row + 16u * (ch ^ (((row & 3) << 2) | ((row >> 2) & 3))); }
__device__ __forceinline__ bf16x8 img_row_frag(const LAS unsigned char* img, unsigned lane, unsigned rb, unsigned s) { return *(const LAS bf16x8*)(img + off_b((lane & 15) + 16 * rb, 4 * s + (lane >> 4))); }
__device__ __forceinline__ bf16x8 img_tr_frag(const LAS unsigned char* img, unsigned lane, unsigned c, unsigned ks) {
    const unsigned g = lane >> 4, q = (lane & 15) >> 2, p = lane & 3;
    const v4i16_t lo = __builtin_amdgcn_ds_read_tr16_b64_v4i16((LAS v4i16_t*)(img + off_b(32 * ks + 8 * g + q, 2 * c + (p >> 1)) + 8 * (p & 1)));
    const v4i16_t hi = __builtin_amdgcn_ds_read_tr16_b64_v4i16((LAS v4i16_t*)(img + off_b(32 * ks + 8 * g + 4 + q, 2 * c + (p >> 1)) + 8 * (p & 1)));
    return (bf16x8){lo[0], lo[1], lo[2], lo[3], hi[0], hi[1], hi[2], hi[3]};
}
__device__ __forceinline__ void img_load(LAS unsigned char* img, const bf16* src, size_t pitch, int rows, int tid) {
    for (int n = tid; n < rows * 16; n += NTHR) { const int row = n >> 4, ch = n & 15; *(LAS v4u*)(img + off_b(row, ch)) = *(const v4u*)(src + (size_t)row * pitch + ch * 8); }
}

__device__ __forceinline__ void p0_transpose_item(const float* W, int K, int Nsrc, int nblk, bf16* WT, const float* kscale, LAS float* scr, int item, int lane) {
    const int kb = item / nblk, nb = item % nblk, k0 = 64 * kb, n0 = 32 * nb;
#pragma unroll 8
    for (int i = 0; i < 32; ++i) { const int kk = 2 * i + (lane >> 5); float v = W[(size_t)(k0 + kk) * Nsrc + n0 + (lane & 31)]; if (kscale) v *= kscale[k0 + kk]; scr[kk * 33 + (lane & 31)] = v; }
    LDS_WAIT(); asm volatile("" ::: "memory");
    const int c = lane & 7;
#pragma unroll
    for (int j = 0; j < 4; ++j) { const int n = (lane >> 3) + 8 * j; const LAS float* s = scr + (8 * c) * 33 + n;
        v4u o; o.x = pk2(s[0 * 33], s[1 * 33]); o.y = pk2(s[2 * 33], s[3 * 33]); o.z = pk2(s[4 * 33], s[5 * 33]); o.w = pk2(s[6 * 33], s[7 * 33]);
        *(GAS v4u*)(WT + (size_t)(n0 + n) * K + k0 + 8 * c) = o; }
    LDS_WAIT(); asm volatile("" ::: "memory");
}
__device__ __forceinline__ void p0_rows(const Args& a, bf16* XN, float* GATES, int gw, int NGW, int lane) {
    const float* x = (const float*)a.in[0]; const float* xs = (const float*)a.in[1]; const float* ln1 = (const float*)a.in[8]; const float* w_in = (const float*)a.in[9]; const float* bg = (const float*)a.in[10];
    f32x4 lw[4], wg[4][4][2];
#pragma unroll
    for (int j = 0; j < 4; ++j) { lw[j] = *(const f32x4*)(ln1 + 4 * lane + 256 * j);
#pragma unroll
        for (int i = 0; i < 4; ++i) { const float* p = w_in + (size_t)(4 * lane + 256 * j + i) * NIN + NZ; wg[j][i][0] = *(const f32x4*)p; wg[j][i][1] = *(const f32x4*)(p + 4); } }
    for (int m = gw; m < MP + SB; m += NGW) {
        const float* xrow = (m < MP) ? x + (size_t)m * DMODEL : xs + (size_t)(m - MP) * DMODEL;
        const GAS f32x4* xr = (const GAS f32x4*)xrow + lane;
        f32x4 v[4]; float s = 0.f;
#pragma unroll
        for (int j = 0; j < 4; ++j) { v[j] = xr[64 * j]; s += (v[j].x * v[j].x + v[j].y * v[j].y) + (v[j].z * v[j].z + v[j].w * v[j].w); }
        const float rs = 1.0f / sqrtf(wave_sum(s) * (1.0f / DMODEL) + RMS_EPS);
        f32x4 g0 = {0.f, 0.f, 0.f, 0.f}, g1 = {0.f, 0.f, 0.f, 0.f};
        GAS unsigned long long* o8 = (GAS unsigned long long*)(XN + (size_t)m * DMODEL) + lane;
#pragma unroll
        for (int j = 0; j < 4; ++j) { const f32x4 y = v[j] * rs * lw[j];
            o8[64 * j] = (unsigned long long)pk2(y.x, y.y) | ((unsigned long long)pk2(y.z, y.w) << 32);
#pragma unroll
            for (int i = 0; i < 4; ++i) { g0 += wg[j][i][0] * y[i]; g1 += wg[j][i][1] * y[i]; } }
#pragma unroll
        for (int i = 0; i < 4; ++i) { g0[i] = wave_sum(g0[i]); g1[i] = wave_sum(g1[i]); }
        if (lane == 0) { *(f32x4*)(GATES + (size_t)m * 8) = g0 + *(const f32x4*)bg; *(f32x4*)(GATES + (size_t)m * 8 + 4) = g1 + *(const f32x4*)(bg + 4); }
    }
}
__device__ __forceinline__ void p0_kmean_unit(const float* cache_k, const int* page_table, float* kms, int unit, LAS float* scr, int tid) {
    const int b = unit >> 5, j = unit & 31, rg = tid >> 7, c4 = tid & 127;
    const int page = page_table[b * NPAGES + 2 * j + (rg >> 1)];
    const f32x4* src = (const f32x4*)(cache_k + ((size_t)page * 128 + (rg & 1) * 64) * 512) + c4;
    f32x4 s = {0.f, 0.f, 0.f, 0.f};
#pragma unroll 16
    for (int r = 0; r < 64; ++r) s += __builtin_nontemporal_load(src + r * 128);
    *(LAS f32x4*)(scr + (rg * 128 + c4) * 4) = s;
    __syncthreads();
    if (tid < 128) { const f32x4 t = (*(LAS f32x4*)(scr + tid * 4) + *(LAS f32x4*)(scr + (128 + tid) * 4)) + (*(LAS f32x4*)(scr + (256 + tid) * 4) + *(LAS f32x4*)(scr + (384 + tid) * 4));
        *(f32x4*)(kms + (size_t)unit * 512 + tid * 4) = t * (1.0f / 256.0f); }
    __syncthreads();
}

__device__ __forceinline__ void ml_local_unit(unsigned char* ws, LAS unsigned char* lds, int u, int tid) {
    const int lane = tid & 63, wid = __builtin_amdgcn_readfirstlane(tid >> 6);
    const int bh = u >> 6, c = u & 63, b = bh >> 2, h = bh & 3; const size_t rowbase = (size_t)b * PS + c * CH;
    const float* GATES = (const float*)(ws + WS_GATES);
    const bf16* KM = (const bf16*)(ws + WS_Z + 4 * Z_STRIDE_B); const bf16* VM = (const bf16*)(ws + WS_Z + 5 * Z_STRIDE_B);
    LAS float* vec = (LAS float*)(lds + ML_VEC);
    if (wid == 0) {
        const float gi = GATES[(rowbase + lane) * 8 + h], gf = GATES[(rowbase + lane) * 8 + 4 + h];
        float bc = log_sigmoid(gf);
#pragma unroll
        for (int o = 1; o < 64; o <<= 1) { const float t = __shfl_up(bc, o); if (lane >= o) bc += t; }
        const float B = __shfl(bc, 63), val = B - bc + gi, amax = wave_max(val);
        vec[lane] = expf(val - amax);
        if (lane == 0) { float* AB = (float*)(ws + WS_SMALL + SM_AB) + (size_t)u * 2; AB[0] = amax; AB[1] = B; }
    }
    __syncthreads();
    for (int n = tid; n < CH * 16; n += NTHR) { const int row = n >> 4, ch = n & 15; const size_t g = (rowbase + row) * 512 + h * MD + ch * 8;
        const v4u kv = *(const v4u*)(KM + g); const float w = vec[row]; v4u o;
        o.x = pk2(bflo(kv.x) * w, bfhi(kv.x) * w); o.y = pk2(bflo(kv.y) * w, bfhi(kv.y) * w); o.z = pk2(bflo(kv.z) * w, bfhi(kv.z) * w); o.w = pk2(bflo(kv.w) * w, bfhi(kv.w) * w);
        *(LAS v4u*)(lds + ML_K + off_b(row, ch)) = o;
        *(LAS v4u*)(lds + ML_V + off_b(row, ch)) = *(const v4u*)(VM + g); }
    __syncthreads();
    {
        const bf16x8 vb0 = img_tr_frag(lds + ML_V, lane, wid, 0), vb1 = img_tr_frag(lds + ML_V, lane, wid, 1);
        bf16* DCT = (bf16*)(ws + WS_DCT) + (size_t)u * 16384 + (size_t)(16 * wid + (lane & 15)) * 128 + 4 * (lane >> 4);
#pragma unroll
        for (int dt = 0; dt < 8; ++dt) { f32x4 acc = {0.f, 0.f, 0.f, 0.f};
            acc = mfma16(img_tr_frag(lds + ML_K, lane, dt, 0), vb0, acc); acc = mfma16(img_tr_frag(lds + ML_K, lane, dt, 1), vb1, acc);
            u32x2 w; w.x = pk2(acc[0], acc[1]); w.y = pk2(acc[2], acc[3]); *(u32x2*)(DCT + 16 * dt) = w; }
    }
    if (tid < 128) { float s = 0.f;
#pragma unroll 8
        for (int r = 0; r < CH; ++r) s += bf2f(*(const LAS bf16*)(lds + ML_K + off_b(r, tid >> 3) + 2 * (tid & 7)));
        ((float*)(ws + WS_SMALL + SM_DN))[(size_t)u * 128 + tid] = s; }
    __syncthreads();
}

__device__ __forceinline__ void ml_scan_unit(const Args& a, LAS unsigned char* lds, int u, int tid) {
    unsigned char* ws = a.ws; const int bh = u >> 4, sl = u & 15;
    LAS float* tA = (LAS float*)(lds + ML_VEC); LAS float* tB = tA + 64; LAS float* dA = tA + 128; LAS float* dB = tA + 192; LAS float* mfin = tA + 256;
    if (tid < 64) { const float* AB = (const float*)(ws + WS_SMALL + SM_AB) + ((size_t)bh * 64 + tid) * 2; tA[tid] = AB[0]; tB[tid] = AB[1]; }
    __syncthreads();
    if (tid == 0) { float m = 0.f; float* MC = (float*)(ws + WS_SMALL + SM_MC) + (size_t)bh * 64;
        for (int c = 0; c < NCH; ++c) { const float mn = fmaxf(tB[c] + m, tA[c]); dA[c] = expf(tB[c] + m - mn); dB[c] = expf(tA[c] - mn); if (sl == 0) MC[c] = m; m = mn; }
        mfin[0] = m; }
    __syncthreads();
    const int e = sl * 8 + (tid >> 6), d = 2 * (tid & 63);
    const unsigned* src = (const unsigned*)((const bf16*)(ws + WS_DCT) + ((size_t)bh * 64 * 128 + e) * 128 + d);
    unsigned* dst = (unsigned*)((bf16*)(ws + WS_CT) + ((size_t)bh * 64 * 128 + e) * 128 + d);
    float c0 = 0.f, c1 = 0.f;
#pragma unroll 8
    for (int c = 0; c < NCH; ++c) { dst[(size_t)c * 8192] = pk2(c0, c1); const unsigned x = src[(size_t)c * 8192]; const float fa = dA[c], fb = dB[c]; c0 = fa * c0 + fb * bflo(x); c1 = fa * c1 + fb * bfhi(x); }
    float* CP = a.out + O_CP + (size_t)bh * 16384; CP[(size_t)d * 128 + e] = c0; CP[(size_t)(d + 1) * 128 + e] = c1;
    if (sl == 0 && tid < 128) { const float* DN = (const float*)(ws + WS_SMALL + SM_DN) + (size_t)bh * 64 * 128 + tid; float* NC = (float*)(ws + WS_SMALL + SM_NC) + (size_t)bh * 64 * 128 + tid; float n = 0.f;
#pragma unroll 8
        for (int c = 0; c < NCH; ++c) { NC[c * 128] = n; n = dA[c] * n + dB[c] * DN[c * 128]; }
        a.out[O_NP + bh * 128 + tid] = n; }
    if (sl == 0 && tid == 0) a.out[O_MPR + bh] = mfin[0];
    __syncthreads();
}

__device__ __forceinline__ void ml_out_unit(const Args& a, LAS unsigned char* lds, int u, int tid) {
    unsigned char* ws = a.ws; const int lane = tid & 63, wid = __builtin_amdgcn_readfirstlane(tid >> 6);
    const int bh = u >> 6, c = u & 63, b = bh >> 2, h = bh & 3; const size_t rowbase = (size_t)b * PS + c * CH;
    const float* GATES = (const float*)(ws + WS_GATES);
    const bf16* QM = (const bf16*)(ws + WS_Z + 3 * Z_STRIDE_B); const bf16* KM = (const bf16*)(ws + WS_Z + 4 * Z_STRIDE_B); const bf16* VM = (const bf16*)(ws + WS_Z + 5 * Z_STRIDE_B); const bf16* OM = (const bf16*)(ws + WS_Z + 6 * Z_STRIDE_B);
    LAS float* vec = (LAS float*)(lds + ML_VEC);
    LAS float* vg = vec, *vG = vec + 64, *vdec = vec + 128, *vfloor = vec + 192, *vrow = vec + 256, *vqn = vec + 320, *vpart = vec + 384  , *vn = vec + 512  ;
    if (wid == 0) {
        const float gi = GATES[(rowbase + lane) * 8 + h], gf = GATES[(rowbase + lane) * 8 + 4 + h];
        const float mc = ((const float*)(ws + WS_SMALL + SM_MC))[u];
        float bc = log_sigmoid(gf);
#pragma unroll
        for (int o = 1; o < 64; o <<= 1) { const float t = __shfl_up(bc, o); if (lane >= o) bc += t; }
        const float g = gi - bc; float gm = g;
#pragma unroll
        for (int o = 1; o < 64; o <<= 1) { const float t = __shfl_up(gm, o); if (lane >= o) gm = fmaxf(gm, t); }
        const float G = fmaxf(mc, gm);
        vg[lane] = g; vG[lane] = G; vdec[lane] = expf(mc - G) * QK_SCALE_M; vfloor[lane] = expf(-(bc + G));
    }
    if (tid >= 64 && tid < 192) vn[tid - 64] = ((const float*)(ws + WS_SMALL + SM_NC))[(size_t)u * 128 + (tid - 64)];
    img_load(lds + ML_Q, QM + rowbase * 512 + h * MD, 512, CH, tid);
    img_load(lds + ML_K, KM + rowbase * 512 + h * MD, 512, CH, tid);
    img_load(lds + ML_V, VM + rowbase * 512 + h * MD, 512, CH, tid);
    img_load(lds + ML_C, (const bf16*)(ws + WS_CT) + (size_t)u * 16384, 128, 128, tid);
    __syncthreads();
    const int tt = wid & 3;
    {
        const int t = 16 * tt + (lane & 15); const float Gt = vG[t];
#pragma unroll
        for (int i = 0; i < 2; ++i) { const int st = 2 * (wid >> 2) + i; f32x4 acc = {0.f, 0.f, 0.f, 0.f};
            if (st <= tt) {
#pragma unroll
                for (int kk = 0; kk < 4; ++kk) acc = mfma16(img_row_frag(lds + ML_K, lane, st, kk), img_row_frag(lds + ML_Q, lane, tt, kk), acc); }
            const int s0 = 16 * st + 4 * (lane >> 4); float p[4];
#pragma unroll
            for (int r = 0; r < 4; ++r) { const int s = s0 + r; p[r] = (s <= t) ? acc[r] * QK_SCALE_M * expf(vg[s] - Gt) : 0.f; }
            u32x2 w; w.x = pk2(p[0], p[1]); w.y = pk2(p[2], p[3]); *(LAS u32x2*)(lds + ML_S + t * ML_SPITCH + s0 * 2) = w; }
    }
    __syncthreads();
    if (tid < 64) { float s = 0.f; const LAS unsigned* rp = (const LAS unsigned*)(lds + ML_S + tid * ML_SPITCH);
#pragma unroll 8
        for (int j = 0; j < 32; ++j) { const unsigned x = rp[j]; s += bflo(x) + bfhi(x); }
        vrow[tid] = s; }
    else if (tid < 128) { const int t = tid - 64; float s = 0.f;
#pragma unroll 4
        for (int ch = 0; ch < 16; ++ch) { const v4u q = *(const LAS v4u*)(lds + ML_Q + off_b(t, ch)); const LAS float* np = vn + ch * 8;
            s += bflo(q.x) * np[0] + bfhi(q.x) * np[1] + bflo(q.y) * np[2] + bfhi(q.y) * np[3] + bflo(q.z) * np[4] + bfhi(q.z) * np[5] + bflo(q.w) * np[6] + bfhi(q.w) * np[7]; }
        vqn[t] = s; }
    f32x4 acc1[4], acc2[4];
    {
        bf16x8 sb[2], qb[4];
#pragma unroll
        for (int ks = 0; ks < 2; ++ks) sb[ks] = *(const LAS bf16x8*)(lds + ML_S + (16 * tt + (lane & 15)) * ML_SPITCH + (32 * ks + 8 * (lane >> 4)) * 2);
#pragma unroll
        for (int kk = 0; kk < 4; ++kk) qb[kk] = img_row_frag(lds + ML_Q, lane, tt, kk);
#pragma unroll
        for (int i = 0; i < 4; ++i) { const int et = 4 * (wid >> 2) + i; f32x4 x = {0.f, 0.f, 0.f, 0.f}, y = {0.f, 0.f, 0.f, 0.f};
#pragma unroll
            for (int ks = 0; ks < 2; ++ks) x = mfma16(img_tr_frag(lds + ML_V, lane, et, ks), sb[ks], x);
#pragma unroll
            for (int kk = 0; kk < 4; ++kk) y = mfma16(img_row_frag(lds + ML_C, lane, et, kk), qb[kk], y);
            acc1[i] = x; acc2[i] = y; }
    }
    __syncthreads();
    const int t = 16 * tt + (lane & 15);
    const float dec = vdec[t], den = vrow[t] + dec * vqn[t], inv = 1.0f / fmaxf(fabsf(den), vfloor[t]);
    float ss = 0.f;
#pragma unroll
    for (int i = 0; i < 4; ++i) { acc1[i] = (acc1[i] + acc2[i] * dec) * inv; ss += (acc1[i][0] * acc1[i][0] + acc1[i][1] * acc1[i][1]) + (acc1[i][2] * acc1[i][2] + acc1[i][3] * acc1[i][3]); }
    ss += __shfl_xor(ss, 16); ss += __shfl_xor(ss, 32);
    if (lane < 16) vpart[(wid >> 2) * 64 + t] = ss;
    __syncthreads();
    const float rs = 1.0f / sqrtf((vpart[t] + vpart[64 + t]) * (1.0f / MD) + RMS_EPS);
    const float* nw = (const float*)a.in[11] + h * MD;
    bf16* MIX = (bf16*)(ws + WS_MIX);
#pragma unroll
    for (int i = 0; i < 4; ++i) { const int e0 = 16 * (4 * (wid >> 2) + i) + 4 * (lane >> 4);
        const u32x2 ow = *(const u32x2*)(OM + (rowbase + t) * 512 + h * MD + e0); const f32x4 g = *(const f32x4*)(nw + e0);
        const float o0 = acc1[i][0] * rs * g[0] * sigmoidf(bflo(ow.x)), o1 = acc1[i][1] * rs * g[1] * sigmoidf(bfhi(ow.x)), o2 = acc1[i][2] * rs * g[2] * sigmoidf(bflo(ow.y)), o3 = acc1[i][3] * rs * g[3] * sigmoidf(bfhi(ow.y));
        u32x2 w; w.x = pk2(o0, o1); w.y = pk2(o2, o3); *(u32x2*)(MIX + (rowbase + t) * DMODEL + 512 + h * MD + e0) = w; }
    __syncthreads();
}

__device__ __forceinline__ void dec_attn_unit(const Args& a, LAS unsigned char* lds, int u, int tid) {
    unsigned char* ws = a.ws; const int lane = tid & 63, wid = __builtin_amdgcn_readfirstlane(tid >> 6); const int b = u >> 3, h = u & 7;
    const float* cache_k = (const float*)a.in[2]; const float* cache_v = (const float*)a.in[3]; const int* pt = (const int*)a.in[4] + b * NPAGES;
    LAS float* sc = (LAS float*)lds; LAS float* red = sc + 1024; LAS int* seli = (LAS int*)(red + 2048); LAS float* misc = (LAS float*)(seli + 8);
    const bf16* qrow = (const bf16*)(ws + WS_Z) + (size_t)(MP + b) * 512 + h * AD;
    if (wid == 0) {
        const int j = lane & 31; const float* km = (const float*)(ws + WS_KMS) + ((size_t)(b * 32 + j)) * 512 + h * AD; float g = 0.f;
#pragma unroll 8
        for (int d = 0; d < AD; ++d) g += bf2f(qrow[d]) * km[d];
#pragma unroll
        for (int k = 0; k < 3; ++k) { float bv = g; int bi = j;
#pragma unroll
            for (int o = 16; o >= 1; o >>= 1) { const float ov = __shfl_xor(bv, o); const int oi = __shfl_xor(bi, o); if (ov > bv || (ov == bv && oi < bi)) { bv = ov; bi = oi; } }
            if (lane == 0) seli[k] = bi; if (j == bi) g = -INFINITY; }
    }
    __syncthreads();
    const int s0 = seli[0], s1 = seli[1], s2 = seli[2];
    const int sub = lane & 15;
    f32x4 q4; { const u32x2 qw = *(const u32x2*)(qrow + 4 * sub); q4 = (f32x4){bflo(qw.x), bfhi(qw.x), bflo(qw.y), bfhi(qw.y)}; }
    for (int it = 0; it < 24; ++it) { const int kk = it * 32 + wid * 4 + (lane >> 4); const int blk = (kk < 256) ? s0 : (kk < 512 ? s1 : s2), pos = kk & 255;
        const int page = pt[2 * blk + (pos >> 7)];
        const f32x4 kv = __builtin_nontemporal_load((const f32x4*)(cache_k + (((size_t)page * 128 + (pos & 127)) * AH + h) * AD) + sub);
        float dsum = (q4[0] * kv[0] + q4[1] * kv[1]) + (q4[2] * kv[2] + q4[3] * kv[3]);
        dsum += __shfl_xor(dsum, 1); dsum += __shfl_xor(dsum, 2); dsum += __shfl_xor(dsum, 4); dsum += __shfl_xor(dsum, 8);
        if (sub == 0) sc[kk] = dsum; }
    if (wid == 0) { const f32x4 kv = *(const f32x4*)(a.out + O_KS + (size_t)b * 512 + h * AD + 4 * sub);
        float dsum = (q4[0] * kv[0] + q4[1] * kv[1]) + (q4[2] * kv[2] + q4[3] * kv[3]);
        dsum += __shfl_xor(dsum, 1); dsum += __shfl_xor(dsum, 2); dsum += __shfl_xor(dsum, 4); dsum += __shfl_xor(dsum, 8);
        if (lane == 0) sc[768] = dsum; }
    __syncthreads();
    if (wid == 0) { float m = -INFINITY;
        for (int i = lane; i < 769; i += 64) m = fmaxf(m, sc[i]);
        m = wave_max(m); float l = 0.f;
        for (int i = lane; i < 769; i += 64) { const float p = exp2f(sc[i] - m); sc[i] = p; l += p; }
        l = wave_sum(l); if (lane == 0) misc[0] = 1.0f / l; }
    __syncthreads();
    { const int g = tid >> 4; f32x4 acc = {0.f, 0.f, 0.f, 0.f};
        for (int i = 0; i < 24; ++i) { const int kk = g + 32 * i; const int blk = (kk < 256) ? s0 : (kk < 512 ? s1 : s2), pos = kk & 255; const int page = pt[2 * blk + (pos >> 7)];
            const f32x4 vv = __builtin_nontemporal_load((const f32x4*)(cache_v + (((size_t)page * 128 + (pos & 127)) * AH + h) * AD) + sub);
            acc += vv * sc[kk]; }
        *(LAS f32x4*)(red + g * 64 + 4 * sub) = acc; }
    __syncthreads();
    if (tid < 64) { float o = 0.f;
#pragma unroll 8
        for (int g = 0; g < 32; ++g) o += red[g * 64 + tid];
        o += sc[768] * a.out[O_VS + (size_t)b * 512 + h * AD + tid];
        ((bf16*)(ws + WS_MIX))[(size_t)(MP + b) * DMODEL + h * AD + tid] = (bf16)f2bf(o * misc[0]); }
    __syncthreads();
}

__device__ __forceinline__ void dec_mlstm_unit(const Args& a, LAS unsigned char* lds, int u, int tid) {
    unsigned char* ws = a.ws; const int b = u >> 2, h = u & 3; const size_t row = MP + b;
    const bf16* QM = (const bf16*)(ws + WS_Z + 3 * Z_STRIDE_B) + row * 512 + h * MD; const bf16* KM = (const bf16*)(ws + WS_Z + 4 * Z_STRIDE_B) + row * 512 + h * MD;
    const bf16* VM = (const bf16*)(ws + WS_Z + 5 * Z_STRIDE_B) + row * 512 + h * MD; const bf16* OM = (const bf16*)(ws + WS_Z + 6 * Z_STRIDE_B) + row * 512 + h * MD;
    const float* GATES = (const float*)(ws + WS_GATES) + row * 8;
    const float* C0 = (const float*)a.in[5] + (size_t)u * 16384; const float* n0 = (const float*)a.in[6] + (size_t)u * 128; const float m0 = ((const float*)a.in[7])[u];
    LAS float* sq = (LAS float*)lds; LAS float* sk = sq + 128; LAS float* part = sk + 128  ; LAS float* sred = part + 512  ;
    const float gi = GATES[h], lf = log_sigmoid(GATES[4 + h]);
    const float mt = fmaxf(lf + m0, gi), wd = expf(gi - mt), dec = expf(lf + m0 - mt);
    if (tid < 128) { const float q = bf2f(QM[tid]), k = bf2f(KM[tid]); sq[tid] = q; sk[tid] = k;
        float qk = q * k, qn = q * n0[tid]; qk = wave_sum(qk); qn = wave_sum(qn);
        if ((tid & 63) == 0) { sred[tid >> 6] = qk; sred[2 + (tid >> 6)] = qn; }
        a.out[O_NS + (size_t)u * 128 + tid] = dec * n0[tid] + wd * k; }
    __syncthreads();
    const int e = tid & 127, dg = tid >> 7; const float v = bf2f(VM[e]);
    float* Cn = a.out + O_CS + (size_t)u * 16384; float acc = 0.f;
#pragma unroll 8
    for (int i = 0; i < 32; ++i) { const int d = dg * 32 + i; const float c0 = C0[(size_t)d * 128 + e]; acc += sq[d] * c0; Cn[(size_t)d * 128 + e] = dec * c0 + wd * sk[d] * v; }
    part[dg * 128 + e] = acc;
    __syncthreads();
    float hval = 0.f;
    if (tid < 128) { const float qk = (sred[0] + sred[1]) * QK_SCALE_M * wd, qn = (sred[2] + sred[3]) * QK_SCALE_M;
        const float num = qk * v + dec * QK_SCALE_M * ((part[e] + part[128 + e]) + (part[256 + e] + part[384 + e]));
        const float den = qk + dec * qn;
        hval = num / fmaxf(fabsf(den), expf(-mt));
        const float s2 = wave_sum(hval * hval); if ((tid & 63) == 0) sred[4 + (tid >> 6)] = s2; }
    __syncthreads();
    if (tid < 128) { const float rs = 1.0f / sqrtf((sred[4] + sred[5]) * (1.0f / MD) + RMS_EPS);
        const float o = hval * rs * ((const float*)a.in[11])[h * MD + e] * sigmoidf(bf2f(OM[e]));
        ((bf16*)(ws + WS_MIX))[row * DMODEL + 512 + h * MD + e] = (bf16)f2bf(o); }
    if (tid == 0) a.out[O_MS + u] = mt;
    __syncthreads();
}

__device__ __forceinline__ float small_gemm16(const bf16* A, int lda, const bf16* Wt, int K, int c0, LAS float* red, int tid) {
    const int lane = tid & 63, wid = __builtin_amdgcn_readfirstlane(tid >> 6); const int kw = K / NWAVES, kbeg = wid * kw;
    const bf16* ap = A + (size_t)(lane & 15) * lda + kbeg + 8 * (lane >> 4);
    const bf16* bp = Wt + (size_t)(c0 + (lane & 15)) * K + kbeg + 8 * (lane >> 4);
    f32x4 acc0 = {0.f, 0.f, 0.f, 0.f}, acc1 = {0.f, 0.f, 0.f, 0.f};
#pragma unroll 4
    for (int k = 0; k < kw; k += 32) { const bf16x8 a0 = *(const bf16x8*)(ap + k), a1 = *(const bf16x8*)(ap + (size_t)16 * lda + k), bb = *(const bf16x8*)(bp + k); acc0 = mfma16(a0, bb, acc0); acc1 = mfma16(a1, bb, acc1); }
#pragma unroll
    for (int r = 0; r < 4; ++r) { red[(wid * 32 + 4 * (lane >> 4) + r) * 16 + (lane & 15)] = acc0[r]; red[(wid * 32 + 16 + 4 * (lane >> 4) + r) * 16 + (lane & 15)] = acc1[r]; }
    __syncthreads();
    float s = 0.f;
#pragma unroll
    for (int w = 0; w < NWAVES; ++w) s += red[w * 512 + tid];
    __syncthreads();
    return s;
}

__global__ void __launch_bounds__(NTHR, 2) hymba_fwd(Args args) {
    extern __shared__ __attribute__((aligned(16))) unsigned char lds_raw[];
    LAS unsigned char* lds = (LAS unsigned char*)lds_raw;
    volatile LAS unsigned* MISC = (volatile LAS unsigned*)(lds + MISC_OFF);
    const int tid = threadIdx.x, lane = tid & 63, wave = __builtin_amdgcn_readfirstlane(tid >> 6);
    const int G = gridDim.x; const int bx = blockIdx.x; const int vcu = (G % 8 == 0) ? (bx % 8) * (G / 8) + bx / 8 : bx;
    unsigned char* ws = args.ws; gu32* ctl = (gu32*)(ws + WS_CTL);
    for (int u = tid; u < (LDS_BYTES - LDSCTL_OFF) / 4; u += NTHR) ((LAS unsigned*)(lds + LDSCTL_OFF))[u] = 0u;
    __syncthreads();
    XcdBarrier bar; bar.bar = (unsigned*)(ctl + CW_BAR); bar.x = 0; bar.st = nullptr;
    if (!MK_PER_PHASE) bar = xcd_barrier_post((unsigned*)(ctl + CW_BAR), MISC + 8);
#define GRID_BAR() do { if (!MK_PER_PHASE) xcd_barrier(bar); } while (0)
    const int lo = args.ph_lo, hi = args.ph_hi;
#define IN(k) (lo <= (k) && (k) < hi)
#define BOTH(k) (IN(k) && IN((k) + 1))
    bf16* WIN_T = (bf16*)(ws + WS_WIN); bf16* WOUT_T = (bf16*)(ws + WS_WOUT); bf16* WUP_T = (bf16*)(ws + WS_WUP); bf16* WDN_T = (bf16*)(ws + WS_WDN);
    bf16* XN = (bf16*)(ws + WS_XN); bf16* ZB = (bf16*)(ws + WS_Z); bf16* MIX = (bf16*)(ws + WS_MIX); bf16* X1B = (bf16*)(ws + WS_X1B); bf16* UB = (bf16*)(ws + WS_U);
    float* X1 = (float*)(ws + WS_X1); float* SSQ1 = (float*)(ws + WS_SSQ1); float* SSQ2 = (float*)(ws + WS_SSQ2); float* GATES = (float*)(ws + WS_GATES);
    float* KMP = (float*)(ws + WS_KMP); float* KMS = (float*)(ws + WS_KMS);
    float* X1S = (float*)(ws + WS_SMALL + SM_X1S); float* X2S = (float*)(ws + WS_SMALL + SM_X2S); bf16* X1SB = (bf16*)(ws + WS_SMALL + SM_X1SB); bf16* USB = (bf16*)(ws + WS_SMALL + SM_US);

    if (IN(0)) {
        LAS float* scr = (LAS float*)(lds + RING_OFF + wave * 16384);
        const int gw = vcu * NWAVES + wave, NGW = G * NWAVES;
        constexpr int I_IN = (DMODEL / 64) * (NZ / 32), I_OUT = (DMODEL / 64) * (DMODEL / 32), I_UP = (DMODEL / 64) * (FF / 32), I_DN = (FF / 64) * (DMODEL / 32);
        for (int it = gw; it < I_IN + I_OUT + I_UP + I_DN; it += NGW) {
            int r = it;
            if (r < I_IN) { p0_transpose_item((const float*)args.in[9], DMODEL, NIN, NZ / 32, WIN_T, nullptr, scr, r, lane); continue; } r -= I_IN;
            if (r < I_OUT) { p0_transpose_item((const float*)args.in[12], DMODEL, DMODEL, DMODEL / 32, WOUT_T, nullptr, scr, r, lane); continue; } r -= I_OUT;
            if (r < I_UP) { p0_transpose_item((const float*)args.in[14], DMODEL, FF, FF / 32, WUP_T, (const float*)args.in[13], scr, r, lane); continue; } r -= I_UP;
            p0_transpose_item((const float*)args.in[15], FF, DMODEL, DMODEL / 32, WDN_T, nullptr, scr, r, lane);
        }
        p0_rows(args, XN, GATES, gw, NGW, lane);
        __syncthreads();
        for (int u = vcu; u < SB * 32; u += G) p0_kmean_unit((const float*)args.in[2], (const int*)args.in[4], KMS, u, (LAS float*)(lds + RING_OFF), tid);
        if (BOTH(0)) GRID_BAR();
    }

    if (IN(1)) {
        pg8::Gemm g{XN, WIN_T, MPAD, NZ, DMODEL}; pg8::StaticOrder S; S.init(MPAD, NZ, G, bx);
        pg8::EpiZ E{ZB, Z_STRIDE_B / 2, attn_body::C2, args.out + O_KP, args.out + O_VP, args.out + O_KS, args.out + O_VS, KMP};
        pg8::gemm_phase<pg8::EpiZ, pg8::StaticOrder, true, true>(lds + RING_OFF, g, S, E);
        if (BOTH(1)) GRID_BAR();
    }

    if (IN(2)) {
        for (int i = vcu * NTHR + tid; i < 32 * 32 * 64; i += G * NTHR) { const int bh8 = i >> 11, j = (i >> 6) & 31, d = i & 63, b = bh8 >> 3, h = bh8 & 7;
            const float v = (j < 16) ? KMP[((size_t)(b * 16 + j)) * 512 + h * AD + d] : 0.f;
            ((bf16*)(ws + WS_SMALL + SM_KMB))[((size_t)bh8 * 64 + j) * 64 + d] = (bf16)f2bf(v); }
        for (int u = vcu; u < 16 * NCH; u += G) ml_local_unit(ws, lds, u, tid);
        if (BOTH(2)) GRID_BAR();
    }

    if (IN(3)) {
        for (int u = vcu; u < 256; u += G) ml_scan_unit(args, lds, u, tid);
        if (BOTH(3)) GRID_BAR();
    }

    if (IN(4)) {
        for (int v = vcu; v < 256; v += G) {
            const int bh = v >> 3, s = v & 7;
#pragma unroll 1
            for (int i = 0; i < 2; ++i) attn_body::attn_unit<8>(bh >> 3, bh & 7, i == 0 ? s : 15 - s, (const attn_body::bf16*)ZB, (const attn_body::bf16*)(ZB + Z_STRIDE_B / 2), (const attn_body::bf16*)(ZB + Z_STRIDE_B),
                                                                   (attn_body::bf16*)MIX, (const attn_body::bf16*)(ws + WS_SMALL + SM_KMB), (char*)lds_raw + RING_OFF);
        }
        __syncthreads();
        for (int u = vcu; u < 16 * NCH; u += G) ml_out_unit(args, lds, u, tid);
        for (int u = vcu; u < SB * AH; u += G) dec_attn_unit(args, lds, u, tid);
        for (int u = vcu; u < SB * MH; u += G) dec_mlstm_unit(args, lds, u, tid);
        if (BOTH(4)) GRID_BAR();
    }

    if (IN(5)) {
        pg8::Gemm g{MIX, WOUT_T, MP, DMODEL, DMODEL}; pg8::StaticOrder S; S.init(MP, DMODEL, G, bx);
        pg8::EpiRes E{(const float*)args.in[0], X1, X1B, SSQ1};
        pg8::gemm_phase<pg8::EpiRes, pg8::StaticOrder, true, true>(lds + RING_OFF, g, S, E);
        for (int cu = vcu; cu < 64; cu += G) { const float v = small_gemm16(MIX + (size_t)MP * DMODEL, DMODEL, WOUT_T, DMODEL, cu * 16, (LAS float*)(lds + RING_OFF), tid);
            const int r = tid >> 4, c = cu * 16 + (tid & 15); const float x1 = ((const float*)args.in[1])[r * DMODEL + c] + v; X1S[r * DMODEL + c] = x1; X1SB[r * DMODEL + c] = (bf16)f2bf(x1); }
        if (BOTH(5)) GRID_BAR();
    }

    if (IN(6)) {
        pg8::Gemm g{X1B, WUP_T, MP, FF, DMODEL}; pg8::StaticOrder S; S.init(MP, FF, G, bx);
        pg8::EpiUp E{UB, SSQ1, RMS_EPS};
        pg8::gemm_phase<pg8::EpiUp, pg8::StaticOrder, true, true>(lds + RING_OFF, g, S, E);
        for (int cu = vcu; cu < 256; cu += G) {
            const int r = tid >> 4; float s = 0.f; { const f32x4* xp = (const f32x4*)(X1S + r * DMODEL + (tid & 15) * 64);
#pragma unroll 4
                for (int i = 0; i < 16; ++i) { const f32x4 x = xp[i]; s += (x[0] * x[0] + x[1] * x[1]) + (x[2] * x[2] + x[3] * x[3]); } }
            s += __shfl_xor(s, 1); s += __shfl_xor(s, 2); s += __shfl_xor(s, 4); s += __shfl_xor(s, 8);
            const float rs = 1.0f / sqrtf(s * (1.0f / DMODEL) + RMS_EPS);
            const float v = small_gemm16(X1SB, DMODEL, WUP_T, DMODEL, cu * 16, (LAS float*)(lds + RING_OFF), tid);
            const float t = fmaxf(v * rs, 0.f); USB[r * FF + cu * 16 + (tid & 15)] = (bf16)f2bf(t * t); }
        if (BOTH(6)) GRID_BAR();
    }

    if (IN(7)) {
        pg8::Gemm g{UB, WDN_T, MP, DMODEL, FF}; pg8::StaticOrder S; S.init(MP, DMODEL, G, bx);
        pg8::EpiRes E{X1, args.out + O_Y, nullptr, SSQ2};
        pg8::gemm_phase<pg8::EpiRes, pg8::StaticOrder, true, true>(lds + RING_OFF, g, S, E);
        for (int cu = vcu; cu < 64; cu += G) { const float v = small_gemm16(USB, FF, WDN_T, FF, cu * 16, (LAS float*)(lds + RING_OFF), tid);
            const int r = tid >> 4, c = cu * 16 + (tid & 15); X2S[r * DMODEL + c] = X1S[r * DMODEL + c] + v; }
        if (BOTH(7)) GRID_BAR();
    }

    if (IN(8)) {
        const int gw = vcu * NWAVES + wave, NGW = G * NWAVES; const float* lnf = (const float*)args.in[16];
        f32x4 lw[4];
#pragma unroll
        for (int j = 0; j < 4; ++j) lw[j] = *(const f32x4*)(lnf + 4 * lane + 256 * j);
        for (int m = gw; m < MP + SB; m += NGW) {
            const bool pr = m < MP; f32x4* yrow = (f32x4*)(pr ? args.out + O_Y + (size_t)m * DMODEL : args.out + O_YS + (size_t)(m - MP) * DMODEL) + lane;
            const f32x4* xrow = pr ? yrow : (const f32x4*)(X2S + (size_t)(m - MP) * DMODEL) + lane;
            f32x4 v[4]; float s = 0.f;
#pragma unroll
            for (int j = 0; j < 4; ++j) { v[j] = xrow[64 * j]; s += (v[j].x * v[j].x + v[j].y * v[j].y) + (v[j].z * v[j].z + v[j].w * v[j].w); }
            const float rs = 1.0f / sqrtf(wave_sum(s) * (1.0f / DMODEL) + RMS_EPS);
#pragma unroll
            for (int j = 0; j < 4; ++j) yrow[64 * j] = v[j] * rs * lw[j];
        }
    }
#undef IN
#undef BOTH
#undef GRID_BAR
}

extern "C" void kernel_launch(void* const* d_in, const int* in_sizes, int n_in, void* d_out, int out_size, void* d_ws, size_t ws_size, hipStream_t stream) {
    static int grid = 0;
    if (grid == 0) {
        if (n_in != 17 || in_sizes[0] != MP * DMODEL || (size_t)out_size != O_END || ws_size < WS_END) { fprintf(stderr, "kernel_launch: unexpected shapes (n_in %d, in0 %d, out %d, ws %zu); nothing launched\n", n_in, n_in > 0 ? in_sizes[0] : -1, out_size, ws_size); grid = -1; return; }
        int dev = 0, cus = 0, per_cu = 0;
        if (hipGetDevice(&dev) != hipSuccess || hipDeviceGetAttribute(&cus, hipDeviceAttributeMultiprocessorCount, dev) != hipSuccess) { fprintf(stderr, "kernel_launch: device query failed\n"); grid = -1; return; }
        if (hipFuncSetAttribute((const void*)hymba_fwd, hipFuncAttributeMaxDynamicSharedMemorySize, LDS_BYTES) != hipSuccess) { fprintf(stderr, "kernel_launch: hipFuncSetAttribute failed\n"); grid = -1; return; }
        if (hipOccupancyMaxActiveBlocksPerMultiprocessor(&per_cu, (const void*)hymba_fwd, NTHR, LDS_BYTES) != hipSuccess || per_cu < 1) fprintf(stderr, "kernel_launch: note: occupancy query reports %d workgroups per CU\n", per_cu);
        (void)hipGetLastError();
        grid = cus;
    }
    if (grid < 0) return;
    if (hipMemsetAsync((char*)d_ws + WS_CTL, 0, CTL_ZERO_BYTES, stream) != hipSuccess) { fprintf(stderr, "kernel_launch: hipMemsetAsync failed\n"); return; }
    Args a{};
    for (int i = 0; i < 17; ++i) a.in[i] = d_in[i];
    a.out = (float*)d_out; a.ws = (unsigned char*)d_ws;
#if MK_PER_PHASE
    for (int p = 0; p < N_PHASES; ++p) { a.ph_lo = p; a.ph_hi = p + 1; hipLaunchKernelGGL(hymba_fwd, dim3(grid), dim3(NTHR), LDS_BYTES, stream, a); }
#else
    a.ph_lo = 0; a.ph_hi = N_PHASES; hipLaunchKernelGGL(hymba_fwd, dim3(grid), dim3(NTHR), LDS_BYTES, stream, a);
#endif
    const hipError_t le = hipPeekAtLastError();
    if (le != hipSuccess) fprintf(stderr, "kernel_launch: launch failed: %s\n", hipGetErrorName(le));
}
```

```cpp
#include <hip/hip_runtime.h>
#include <hip/hip_bf16.h>
#include <cstdio>
#include <cstdint>
#include <cmath>
namespace pg8 {
#define PG8_LAS __attribute__((address_space(3)))
typedef unsigned short bf16_t;
typedef short bf16x8 __attribute__((ext_vector_type(8)));
typedef float f32x4 __attribute__((ext_vector_type(4)));
typedef unsigned u32x4 __attribute__((ext_vector_type(4)));
constexpr int BM = 256, BK = 64, HALF = 128, HTB = HALF * BK * 2  , STAGE_BYTES = 8 * HTB, NXCD = 8, WGM = 8;

__host__ __device__ __forceinline__ int lds_byte(int r, int c) { const int st = (r >> 4) * 2 + (c >> 5), rr = r & 15, cc = c & 31, ob = rr * 64 + cc * 2; return st * 1024 + (ob ^ (((ob >> 9) & 1) << 5)); }
__host__ __device__ __forceinline__ void stage_rc(int b, int& R, int& C) { const int st = b / 1024, sb = b % 1024, swz = sb ^ (((sb >> 9) & 1) << 5); R = (st >> 1) * 16 + swz / 64; C = (st & 1) * 32 + (swz % 64) / 2; }
__host__ __device__ __forceinline__ int perm32(int rho) { const int n = rho >> 4, i = rho & 15; return 8 * (i >> 2) + 4 * n + (i & 3); }

struct Unit { int pm, pn; };
struct Gemm { const bf16_t* A; const bf16_t* Bt; int M, N, K; };

struct StaticOrder {
    int nM, nN, nwg, G, c;
    __host__ __device__ void init(int M, int N, int G_, int c_) { nM = M / BM; nN = N / BM; nwg = nM * nN; G = G_; c = c_; }
    __host__ __device__ bool next(int i, Unit& u) const {
        const long L = (long)i * G + c; if (L >= nwg) return false;
        int wgid = (int)L; { const int q = nwg / NXCD, r = nwg % NXCD, xcd = wgid % NXCD, off = wgid / NXCD; wgid = (xcd < r ? xcd * (q + 1) : r * (q + 1) + (xcd - r) * q) + off; }
        const int nig = WGM * nN, gid = wgid / nig, fm = gid * WGM, gsz = (nM - fm) < WGM ? (nM - fm) : WGM;
        u.pm = fm + ((wgid % nig) % gsz); u.pn = (wgid % nig) / gsz; return true;
    }
    __device__ __forceinline__ void a_ready(const Unit&) const {}
    __device__ __forceinline__ void done(const Unit&) const {}
};

__device__ __forceinline__ unsigned cvt_pk_bf16(float lo, float hi) { unsigned r; asm volatile("v_cvt_pk_bf16_f32 %0, %1, %2" : "=v"(r) : "v"(lo), "v"(hi)); return r; }
typedef unsigned u32x2 __attribute__((ext_vector_type(2)));

struct EpiZ {
    static constexpr bool PERM = true, AFTER_DRAIN = false;
    bf16_t* Z; size_t zstride; float qscale; float* kp; float* vp; float* ks; float* vs; float* kmean;
    __device__ __forceinline__ void operator()(const f32x4 (&acc)[2][2][4][2], const Unit& u, int wr, int wc, int fr, int fq) const {
        const int t = u.pn >> 1, colt = (u.pn & 1) * BM;
        bf16_t* base = Z + (size_t)t * zstride;
        const float sc = (t == 0) ? qscale : 1.f;
        const int lrow0 = wr * 64 + fr, col0 = colt + wc * 32 + 8 * fq;
        const bool kv = (t == 1 || t == 2);
        float* fdst = nullptr; int nvalid = 0;
        if (kv) { if (u.pm < 64) { fdst = (t == 1 ? kp : vp) + (size_t)u.pm * BM * 512; nvalid = BM; } else { fdst = (t == 1 ? ks : vs); nvalid = 32; } }
#pragma unroll
        for (int ai = 0; ai < 2; ++ai)
#pragma unroll
            for (int m = 0; m < 4; ++m) { const int lrow = lrow0 + ai * HALF + m * 16; bf16_t* rowp = base + (size_t)(u.pm * BM + lrow) * 512 + col0;
#pragma unroll
                for (int bj = 0; bj < 2; ++bj) { const f32x4 v0 = acc[ai][bj][m][0] * sc, v1 = acc[ai][bj][m][1] * sc;
                    u32x4 w; w.x = cvt_pk_bf16(v0[0], v0[1]); w.y = cvt_pk_bf16(v0[2], v0[3]); w.z = cvt_pk_bf16(v1[0], v1[1]); w.w = cvt_pk_bf16(v1[2], v1[3]);
                    *(u32x4*)(rowp + bj * HALF) = w;
                    if (kv && lrow < nvalid) { float* fp = fdst + (size_t)lrow * 512 + col0 + bj * HALF; *(f32x4*)fp = acc[ai][bj][m][0]; *(f32x4*)(fp + 4) = acc[ai][bj][m][1]; } } }
        if (t == 1 && u.pm < 64) {
            float* km = kmean + (size_t)u.pm * 512 + col0;
#pragma unroll
            for (int bj = 0; bj < 2; ++bj)
#pragma unroll
                for (int n = 0; n < 2; ++n) { f32x4 s = acc[0][bj][0][n];
#pragma unroll
                    for (int m = 1; m < 4; ++m) s += acc[0][bj][m][n];
#pragma unroll
                    for (int m = 0; m < 4; ++m) s += acc[1][bj][m][n];
#pragma unroll
                    for (int i = 0; i < 4; ++i) { float x = s[i]; x += __shfl_xor(x, 1); x += __shfl_xor(x, 2); x += __shfl_xor(x, 4); x += __shfl_xor(x, 8);
                        if (fr == 0) __hip_atomic_fetch_add(km + bj * HALF + 4 * n + i, x * (1.0f / 256.0f), __ATOMIC_RELAXED, __HIP_MEMORY_SCOPE_AGENT); }
                    asm volatile("" ::: "memory"); }
        }
    }
};

struct EpiRes {
    static constexpr bool PERM = false, AFTER_DRAIN = false;
    const float* res; float* out; bf16_t* outb; float* ssq;
    __device__ __forceinline__ void operator()(const f32x4 (&acc)[2][2][4][2], const Unit& u, int wr, int wc, int fr, int fq) const {
        const int row0 = u.pm * BM + wr * 64 + fr, col0 = u.pn * BM + wc * 32 + 4 * fq;
#pragma unroll
        for (int ai = 0; ai < 2; ++ai)
#pragma unroll
            for (int m = 0; m < 4; ++m) { const int row = row0 + ai * HALF + m * 16; const size_t off = (size_t)row * 1024 + col0; float s = 0.f;
#pragma unroll
                for (int bj = 0; bj < 2; ++bj)
#pragma unroll
                    for (int n = 0; n < 2; ++n) { const f32x4 v = *(const f32x4*)(res + off + bj * HALF + n * 16) + acc[ai][bj][m][n];
                        *(f32x4*)(out + off + bj * HALF + n * 16) = v; s += (v[0] * v[0] + v[1] * v[1]) + (v[2] * v[2] + v[3] * v[3]);
                        if (outb) { u32x2 w; w.x = cvt_pk_bf16(v[0], v[1]); w.y = cvt_pk_bf16(v[2], v[3]); *(u32x2*)(outb + off + bj * HALF + n * 16) = w; } }
                s += __shfl_xor(s, 16); s += __shfl_xor(s, 32);
                if (fq == 0) ssq[(size_t)row * 16 + u.pn * 4 + wc] = s; }
    }
};

struct EpiUp {
    static constexpr bool PERM = true, AFTER_DRAIN = false;
    bf16_t* O; const float* ssq; float eps;
    __device__ __forceinline__ void operator()(const f32x4 (&acc)[2][2][4][2], const Unit& u, int wr, int wc, int fr, int fq) const {
        const int row0 = u.pm * BM + wr * 64 + fr, col0 = u.pn * BM + wc * 32 + 8 * fq;
#pragma unroll
        for (int ai = 0; ai < 2; ++ai)
#pragma unroll
            for (int m = 0; m < 4; ++m) { const int row = row0 + ai * HALF + m * 16;
                const f32x4 q = *(const f32x4*)(ssq + (size_t)row * 16 + 4 * fq); float s = (q[0] + q[1]) + (q[2] + q[3]);
                s += __shfl_xor(s, 16); s += __shfl_xor(s, 32);
                const float rs = 1.0f / sqrtf(s * (1.0f / 1024.0f) + eps);
                bf16_t* rowp = O + (size_t)row * 4096 + col0;
#pragma unroll
                for (int bj = 0; bj < 2; ++bj) { f32x4 v0 = acc[ai][bj][m][0] * rs, v1 = acc[ai][bj][m][1] * rs;
#pragma unroll
                    for (int i = 0; i < 4; ++i) { const float a = fmaxf(v0[i], 0.f), b = fmaxf(v1[i], 0.f); v0[i] = a * a; v1[i] = b * b; }
                    u32x4 w; w.x = cvt_pk_bf16(v0[0], v0[1]); w.y = cvt_pk_bf16(v0[2], v0[3]); w.z = cvt_pk_bf16(v1[0], v1[1]); w.w = cvt_pk_bf16(v1[2], v1[3]);
                    *(u32x4*)(rowp + bj * HALF) = w; } }
    }
};

template <class Epi, class Sched, bool ALIGN_EPI = false, bool SP2 = false>
__device__ __forceinline__ void gemm_phase(PG8_LAS unsigned char* lds, const Gemm g, const Sched& S, const Epi& E) {
    const int tid = threadIdx.x, wid = __builtin_amdgcn_readfirstlane(tid >> 6), lane = tid & 63, wr = wid >> 2, wc = wid & 3, fr = lane & 15, fq = lane >> 4;
    const int K = g.K, nt = K / BK;
    unsigned voffA[2], voffB[2];
#pragma unroll
    for (int i = 0; i < 2; ++i) { int R, C; stage_rc(tid * 16 + i * 8192, R, C); const int Rb = Epi::PERM ? ((R & ~31) + perm32(R & 31)) : R;
        voffA[i] = (unsigned)(R * K + C) * 2u; voffB[i] = (unsigned)(Rb * K + C) * 2u; }
    const size_t kstep = (size_t)(BK * 2);
    const size_t hstep = (size_t)HALF * K * 2;
    const size_t tstep = 2 * hstep;
    const unsigned ldsw = (unsigned)wid * 1024u;
    const int aoff = lds_byte(wr * 64 + fr, fq * 8), boff = lds_byte(wc * 32 + fr, fq * 8);
#define PG8_SA(b, h) (((b) * 2 + (h)) * HTB)
#define PG8_SB(b, h) ((4 + (b) * 2 + (h)) * HTB)
#define PG8_STAGE(bufoff, gbase, voff) do { _Pragma("unroll") for (int _i = 0; _i < 2; ++_i) \
        __builtin_amdgcn_global_load_lds((const unsigned*)((const char*)(gbase) + (voff)[_i]), (PG8_LAS unsigned*)(lds + (bufoff) + ldsw + _i * 8192), 16, 0, 0); } while (0)
#define PG8_LDA(dst, b, h) do { _Pragma("unroll") for (int m = 0; m < 4; ++m) _Pragma("unroll") for (int k = 0; k < 2; ++k) dst[m][k] = *(const PG8_LAS bf16x8*)(lds + PG8_SA(b, h) + aoff + m * 2048 + k * 1024); } while (0)
#define PG8_LDB(dst, b, h) do { _Pragma("unroll") for (int n = 0; n < 2; ++n) _Pragma("unroll") for (int k = 0; k < 2; ++k) dst[n][k] = *(const PG8_LAS bf16x8*)(lds + PG8_SB(b, h) + boff + n * 2048 + k * 1024); } while (0)
#define PG8_MMA(ai, bj, At, Bt) do { __builtin_amdgcn_s_setprio(1); _Pragma("unroll") for (int m = 0; m < 4; ++m) _Pragma("unroll") for (int n = 0; n < 2; ++n) _Pragma("unroll") for (int k = 0; k < 2; ++k) \
        acc[ai][bj][m][n] = __builtin_amdgcn_mfma_f32_16x16x32_bf16(Bt[n][k], At[m][k], acc[ai][bj][m][n], 0, 0, 0); __builtin_amdgcn_s_setprio(0); } while (0)
#define PG8_WAIT_V(n) asm volatile("s_waitcnt vmcnt(" #n ")" ::: "memory")
#define PG8_WAIT_L(n) asm volatile("s_waitcnt lgkmcnt(" #n ")" ::: "memory")
#define PG8_BAR __builtin_amdgcn_s_barrier()
#define PG8_SCHED __builtin_amdgcn_sched_barrier(0)
    Unit cur, nxt; int ui = 0;
    if (!S.next(0, cur)) return;
    f32x4 acc[2][2][4][2];
#pragma unroll
    for (int a = 0; a < 2; ++a)
#pragma unroll
        for (int b = 0; b < 2; ++b)
#pragma unroll
            for (int m = 0; m < 4; ++m)
#pragma unroll
                for (int n = 0; n < 2; ++n) acc[a][b][m][n] = (f32x4){0.f, 0.f, 0.f, 0.f};
    bf16x8 At[4][2], B0[2][2], B1[2][2];
    const char* cA = (const char*)g.A + (size_t)cur.pm * tstep; const char* cB = (const char*)g.Bt + (size_t)cur.pn * tstep;
    S.a_ready(cur);
    if constexpr (SP2) {
        PG8_STAGE(PG8_SB(0, 0), cB, voffB); PG8_STAGE(PG8_SB(0, 1), cB + hstep, voffB); PG8_STAGE(PG8_SA(0, 0), cA, voffA); PG8_STAGE(PG8_SA(0, 1), cA + hstep, voffA);
        if (wr == 1) PG8_BAR;
        PG8_WAIT_V(2); PG8_BAR;
        PG8_STAGE(PG8_SB(1, 0), cB + kstep, voffB); PG8_STAGE(PG8_SA(1, 0), cA + kstep, voffA); PG8_STAGE(PG8_SB(1, 1), cB + hstep + kstep, voffB);
        PG8_WAIT_V(6); PG8_BAR;
    } else {
        PG8_STAGE(PG8_SB(0, 0), cB, voffB); PG8_STAGE(PG8_SA(0, 0), cA, voffA); PG8_STAGE(PG8_SB(0, 1), cB + hstep, voffB); PG8_STAGE(PG8_SA(0, 1), cA + hstep, voffA);
        if (wr == 1) PG8_BAR;
        PG8_WAIT_V(4); PG8_BAR;
        PG8_STAGE(PG8_SB(1, 0), cB + kstep, voffB); PG8_STAGE(PG8_SA(1, 0), cA + kstep, voffA); PG8_STAGE(PG8_SB(1, 1), cB + hstep + kstep, voffB);
        PG8_WAIT_V(6); PG8_BAR;
    }
    for (;;) {
        const bool has_next = S.next(ui + 1, nxt);
        const char* nA = has_next ? (const char*)g.A + (size_t)nxt.pm * tstep : cA; const char* nB = has_next ? (const char*)g.Bt + (size_t)nxt.pn * tstep : cB;
        for (int t = 0; t < nt; t += 2) {
            const bool last = (t == nt - 2);
            const char* a1 = cA + (size_t)(t + 1) * kstep;
            const char* a2 = last ? nA : cA + (size_t)(t + 2) * kstep; const char* b2 = last ? nB : cB + (size_t)(t + 2) * kstep;
            const char* a3 = a2 + kstep; const char* b3 = b2 + kstep;
            if (last && has_next) S.a_ready(nxt);
            if constexpr (SP2) {
            PG8_LDB(B0, 0, 0); PG8_LDB(B1, 0, 1); PG8_SCHED; PG8_LDA(At, 0, 0); PG8_STAGE(PG8_SA(1, 1), a1 + hstep, voffA);
            PG8_WAIT_V(8); PG8_WAIT_L(0); PG8_BAR; PG8_MMA(0, 0, At, B0); PG8_MMA(0, 1, At, B1); PG8_BAR; PG8_SCHED;
            PG8_LDA(At, 0, 1); PG8_STAGE(PG8_SB(0, 0), b2, voffB); PG8_STAGE(PG8_SB(0, 1), b2 + hstep, voffB); PG8_STAGE(PG8_SA(0, 0), a2, voffA);
            PG8_WAIT_V(8); PG8_WAIT_L(0); PG8_BAR; PG8_MMA(1, 0, At, B0); PG8_MMA(1, 1, At, B1); PG8_BAR; PG8_SCHED;
            PG8_LDB(B0, 1, 0); PG8_LDB(B1, 1, 1); PG8_SCHED; PG8_LDA(At, 1, 0); PG8_STAGE(PG8_SA(0, 1), a2 + hstep, voffA);
            PG8_WAIT_V(8); PG8_WAIT_L(0); PG8_BAR; PG8_MMA(0, 0, At, B0); PG8_MMA(0, 1, At, B1); PG8_BAR; PG8_SCHED;
            PG8_LDA(At, 1, 1); PG8_STAGE(PG8_SB(1, 0), b3, voffB); PG8_STAGE(PG8_SB(1, 1), b3 + hstep, voffB); PG8_STAGE(PG8_SA(1, 0), a3, voffA);
            PG8_WAIT_V(8); PG8_WAIT_L(0); PG8_BAR; PG8_MMA(1, 0, At, B0); PG8_MMA(1, 1, At, B1); PG8_BAR; PG8_SCHED;
            } else {
            PG8_LDB(B0, 0, 0); PG8_SCHED; PG8_LDA(At, 0, 0); PG8_STAGE(PG8_SA(1, 1), a1 + hstep, voffA);
            PG8_WAIT_L(8); PG8_BAR; PG8_WAIT_L(0); PG8_MMA(0, 0, At, B0); PG8_BAR; PG8_SCHED;
            PG8_LDB(B1, 0, 1); PG8_STAGE(PG8_SB(0, 0), b2, voffB);
            PG8_BAR; PG8_WAIT_L(0); PG8_MMA(0, 1, At, B1); PG8_BAR;
            PG8_LDA(At, 0, 1); PG8_STAGE(PG8_SA(0, 0), a2, voffA);
            PG8_BAR; PG8_WAIT_L(0); PG8_MMA(1, 0, At, B0); PG8_BAR; PG8_SCHED;
            PG8_STAGE(PG8_SB(0, 1), b2 + hstep, voffB);
            PG8_WAIT_V(6); PG8_BAR; PG8_MMA(1, 1, At, B1); PG8_BAR;
            PG8_LDB(B0, 1, 0); PG8_SCHED; PG8_LDA(At, 1, 0); PG8_STAGE(PG8_SA(0, 1), a2 + hstep, voffA);
            PG8_WAIT_L(8); PG8_BAR; PG8_WAIT_L(0); PG8_MMA(0, 0, At, B0); PG8_BAR; PG8_SCHED;
            PG8_LDB(B1, 1, 1); PG8_STAGE(PG8_SB(1, 0), b3, voffB);
            PG8_BAR; PG8_WAIT_L(0); PG8_MMA(0, 1, At, B1); PG8_BAR;
            PG8_LDA(At, 1, 1); PG8_STAGE(PG8_SA(1, 0), a3, voffA);
            PG8_BAR; PG8_WAIT_L(0); PG8_MMA(1, 0, At, B0); PG8_BAR; PG8_SCHED;
            PG8_STAGE(PG8_SB(1, 1), b3 + hstep, voffB);
            PG8_WAIT_V(6); PG8_BAR; PG8_MMA(1, 1, At, B1); PG8_BAR;
            }
        }
        if constexpr (ALIGN_EPI) { if (wr == 0) PG8_BAR; }
        if constexpr (!Epi::AFTER_DRAIN) { E(acc, cur, wr, wc, fr, fq); S.done(cur); }
        if (!has_next) break;
#pragma unroll
        for (int a = 0; a < 2; ++a)
#pragma unroll
            for (int b = 0; b < 2; ++b)
#pragma unroll
                for (int m = 0; m < 4; ++m)
#pragma unroll
                    for (int n = 0; n < 2; ++n) acc[a][b][m][n] = (f32x4){0.f, 0.f, 0.f, 0.f};
        cur = nxt; cA = nA; cB = nB; ++ui;
        if constexpr (ALIGN_EPI) { if (wr == 1) PG8_BAR; }
    }
    PG8_WAIT_V(0);
    if constexpr (!ALIGN_EPI) { if (wr == 0) PG8_BAR; }
    PG8_BAR;
    if constexpr (Epi::AFTER_DRAIN) { E.fused(acc, cur, wr, wc, fr, fq, lds, wid, lane); S.done(cur); }
#undef PG8_SA
#undef PG8_SB
#undef PG8_STAGE
#undef PG8_LDA
#undef PG8_LDB
#undef PG8_MMA
#undef PG8_WAIT_V
#undef PG8_WAIT_L
#undef PG8_BAR
#undef PG8_SCHED
}
}
namespace attn_body {
using bf16=__hip_bfloat16;
using bf16x8=__attribute__((ext_vector_type(8)))short;
using s16x4=__attribute__((ext_vector_type(4)))short;
using f32x16=__attribute__((ext_vector_type(16)))float;
using u32x4=__attribute__((ext_vector_type(4)))unsigned;
constexpr int BATCH=4,NHEAD=8,SEQ=4096,D=64,DM=NHEAD*D,OP=1024;
constexpr int NW=8,QBLK=32,QB=QBLK*NW,KVBLK=64,NQB=SEQ/QB;
constexpr int ATTN_PITCH=DM, ATTN_UNIT_ROWS=QB;
__device__ __forceinline__ int crow(int r,int hi){return (r&3)+8*(r>>2)+4*hi;}
#define SBAR() __builtin_amdgcn_sched_barrier(0)
__device__ __forceinline__ void cmask(f32x16&p0,f32x16&p1,int jb,int qrel,int hi){
  const float NEG=-INFINITY; int kb=64*jb+4*hi;
  #pragma unroll
  for(int r=0;r<16;++r){int kv=kb+(r&3)+8*(r>>2); if(kv>qrel)p0[r]=NEG; if(kv+32>qrel)p1[r]=NEG;}
}

constexpr int NSLOT=3, SLOTB=8192;
constexpr int LDS_K=0, LDS_V=NSLOT*SLOTB, LDS_WS=2*NSLOT*SLOTB, LDS_OST=LDS_WS+NW*64*4, LDS_BYTES=LDS_OST+NW*4096;
constexpr float C2=0.125f*1.4426950408889634f;
__device__ __forceinline__ void glds16(const void*gsrc,unsigned lds_dst){unsigned keep;
  asm volatile("s_mov_b32 %0, m0\n\ts_mov_b32 m0, %2\n\ts_nop 0\n\tglobal_load_lds_dwordx4 %1, off\n\ts_mov_b32 m0, %0":"=&s"(keep):"v"(gsrc),"s"(lds_dst):"memory");}
__device__ __forceinline__ float max3f(float a,float b,float c){float r;asm("v_max3_f32 %0, %1, %2, %3":"=v"(r):"v"(a),"v"(b),"v"(c));return r;}
__device__ __forceinline__ float max2f(float a,float b){float r;asm("v_max_f32_e32 %0, %1, %2":"=v"(r):"v"(a),"v"(b));return r;}
__device__ __forceinline__ float fadd_s(float a,float b){float r;asm("v_add_f32_e32 %0, %1, %2":"=v"(r):"v"(a),"v"(b));return r;}
__device__ __forceinline__ float fsub_s(float a,float b){float r;asm("v_sub_f32_e32 %0, %1, %2":"=v"(r):"v"(a),"v"(b));return r;}
typedef float f32x2_t __attribute__((ext_vector_type(2))); typedef __bf16 bf16x2_t __attribute__((ext_vector_type(2)));
__device__ __forceinline__ unsigned cvtpk_s(float lo,float hi){f32x2_t v={lo,hi};bf16x2_t b=__builtin_convertvector(v,bf16x2_t);return __builtin_bit_cast(unsigned,b);}
#define WAIT_BAR(N) asm volatile("s_waitcnt vmcnt(" #N ") lgkmcnt(0)\n\ts_barrier":::"memory")

__device__ __forceinline__ void qkt(f32x16&p0,f32x16&p1,const char*Kslot,const bf16x8*qr,int r32,int hi){ const f32x16 zc=f32x16{};
  const char*kb=Kslot+hi*1024+r32*16;
  #pragma unroll
  for(int d0=0;d0<4;++d0){
    const bf16x8 b0=*reinterpret_cast<const bf16x8*>(kb+d0*2048);
    const bf16x8 b1=*reinterpret_cast<const bf16x8*>(kb+d0*2048+512);
    if(d0==0){p0=__builtin_amdgcn_mfma_f32_32x32x16_bf16(b0,qr[0],zc,0,0,0);p1=__builtin_amdgcn_mfma_f32_32x32x16_bf16(b1,qr[0],zc,0,0,0);}
    else{p0=__builtin_amdgcn_mfma_f32_32x32x16_bf16(b0,qr[d0],p0,0,0,0);p1=__builtin_amdgcn_mfma_f32_32x32x16_bf16(b1,qr[d0],p1,0,0,0);}}
}
typedef __attribute__((address_space(3))) const char* lds_cptr;
typedef short v4i16_t __attribute__((ext_vector_type(4)));
__device__ __forceinline__ void kload8(bf16x8*kf,lds_cptr kp){
  kf[0]=*(const __attribute__((address_space(3))) bf16x8*)(kp);      kf[1]=*(const __attribute__((address_space(3))) bf16x8*)(kp+512);
  kf[2]=*(const __attribute__((address_space(3))) bf16x8*)(kp+2048); kf[3]=*(const __attribute__((address_space(3))) bf16x8*)(kp+2560);
  kf[4]=*(const __attribute__((address_space(3))) bf16x8*)(kp+4096); kf[5]=*(const __attribute__((address_space(3))) bf16x8*)(kp+4608);
  kf[6]=*(const __attribute__((address_space(3))) bf16x8*)(kp+6144); kf[7]=*(const __attribute__((address_space(3))) bf16x8*)(kp+6656);
}
__device__ __forceinline__ void kload2(bf16x8*kf,lds_cptr kp,int j){ kf[2*j]=*(const __attribute__((address_space(3))) bf16x8*)(kp+j*2048); kf[2*j+1]=*(const __attribute__((address_space(3))) bf16x8*)(kp+j*2048+512); }
__device__ __forceinline__ s16x4 vtr(lds_cptr p){ return __builtin_bit_cast(s16x4,__builtin_amdgcn_ds_read_tr16_b64_v4i16((__attribute__((address_space(3))) v4i16_t*)p)); }
__device__ __forceinline__ float rowmax(const f32x16&p0,const f32x16&p1){
  float a=max3f(p0[0],p0[1],p1[0]),b=max3f(p0[2],p0[3],p1[1]);a=max3f(a,p1[2],p1[3]);
  #pragma unroll
  for(int r=4;r<16;r+=4){a=max3f(a,p0[r],p0[r+1]);b=max3f(b,p0[r+2],p0[r+3]);a=max3f(a,p1[r],p1[r+1]);b=max3f(b,p1[r+2],p1[r+3]);}
  const float m=max2f(a,b);
  auto rr=__builtin_amdgcn_permlane32_swap(__float_as_uint(m),__float_as_uint(m),false,false);
  return max2f(__uint_as_float(rr[0]),__uint_as_float(rr[1]));
}
__device__ __forceinline__ void pv(f32x16*o,int vb,bf16x8 pa0,bf16x8 pa1,bf16x8 pa2,bf16x8 pa3){
  #pragma unroll
  for(int d0=0;d0<2;++d0){s16x4 lo[4],hi[4];
    #pragma unroll
    for(int ks=0;ks<4;++ks){
      asm volatile("ds_read_b64_tr_b16 %0,%1 offset:%c2":"=&v"(lo[ks]):"v"(vb),"i"(d0*4096+ks*1024):"memory");
      asm volatile("ds_read_b64_tr_b16 %0,%1 offset:%c2":"=&v"(hi[ks]):"v"(vb),"i"(d0*4096+ks*1024+512):"memory");}
    asm volatile("s_waitcnt lgkmcnt(0)":::"memory");SBAR();
    #define PK(k) (bf16x8){lo[k][0],lo[k][1],lo[k][2],lo[k][3],hi[k][0],hi[k][1],hi[k][2],hi[k][3]}
    o[d0]=__builtin_amdgcn_mfma_f32_32x32x16_bf16(pa0,PK(0),o[d0],0,0,0);
    o[d0]=__builtin_amdgcn_mfma_f32_32x32x16_bf16(pa1,PK(1),o[d0],0,0,0);
    o[d0]=__builtin_amdgcn_mfma_f32_32x32x16_bf16(pa2,PK(2),o[d0],0,0,0);
    o[d0]=__builtin_amdgcn_mfma_f32_32x32x16_bf16(pa3,PK(3),o[d0],0,0,0);
    #undef PK
  }
}

#ifndef ATTN_STORE16
#define ATTN_STORE16(p,v) (*(u32x4*)(p)=(v))
#endif
template<int THRL> __device__ __forceinline__ void attn_unit(int b,int h,int qb,const bf16*Q,const bf16*__restrict__ K,const bf16*__restrict__ V,bf16*O,const bf16*__restrict__ KM,char*shm){
  const int tid=threadIdx.x,lane=tid&63,r32=lane&31,hi=lane>>5; const int wid=__builtin_amdgcn_readfirstlane(tid>>6);
  const long rowbase=(long)b*SEQ; const int q0=qb*QB;
  const bf16*Qw=Q+(rowbase+q0+wid*QBLK)*DM+h*D;
  const bf16*Kh=K+rowbase*DM+h*D,*Vh=V+rowbase*DM+h*D;
  const unsigned lds0=(unsigned)(uintptr_t)shm;
  float*wsf=(float*)(shm+LDS_WS)+wid*64;
  const bf16*ksrc=Kh+(long)lane*DM+wid*8;
  const bf16*vsrc=Vh+(long)(16*(wid&3)+(lane>>2))*DM+(wid>>2)*32+(lane&3)*8;
  const unsigned kdst=lds0+LDS_K+wid*1024, vdst=lds0+LDS_V+wid*1024;
  #define DMA_K(t,slot) glds16(ksrc+(long)(t)*KVBLK*DM,(unsigned)__builtin_amdgcn_readfirstlane(kdst+(slot)))
  #define DMA_V(t,slot) glds16(vsrc+(long)(t)*KVBLK*DM,(unsigned)__builtin_amdgcn_readfirstlane(vdst+(slot)))
  const int vb0=(int)(lds0+LDS_V)+((lane>>4)&1)*32+(lane&3)*8+(4*hi+((lane&15)>>2))*64;
  const char*Kbase=shm+LDS_K; bf16x8 kf[8];
  const lds_cptr shm3=(lds_cptr)shm; const lds_cptr kp0=shm3+LDS_K+hi*1024+r32*16; const lds_cptr vp0=shm3+LDS_V+((lane>>4)&1)*32+(lane&3)*8+(4*hi+((lane&15)>>2))*64;
  const int NT=(q0+QB)/KVBLK;
  bf16x8 qr[4];
  #pragma unroll
  for(int d0=0;d0<4;++d0)qr[d0]=*reinterpret_cast<const bf16x8*>(&Qw[(long)r32*DM+d0*16+hi*8]);
  unsigned sel=(1u<<qb)-1u;
  if(qb>3){
    glds16(KM+((long)(b*NHEAD+h)*64+lane)*64+wid*8,(unsigned)__builtin_amdgcn_readfirstlane(kdst));
    WAIT_BAR(0);
    f32x16 g=f32x16{};
    { const char*kb=shm+LDS_K+hi*1024+r32*16;
      #pragma unroll
      for(int d0=0;d0<4;++d0){const bf16x8 b0=*reinterpret_cast<const bf16x8*>(kb+d0*2048); g=__builtin_amdgcn_mfma_f32_32x32x16_bf16(b0,qr[d0],g,0,0,0);} }
    float gv[16];
    #pragma unroll
    for(int r=0;r<8;++r){const float mine=g[r]; const float oth=__shfl_xor(mine,32);
      const int jlo=(r&3)+8*(r>>2), jhi=jlo+4; gv[jlo]=hi?oth:mine; gv[jhi]=hi?mine:oth; }
    #pragma unroll
    for(int j=0;j<16;++j) if(j>=qb) gv[j]=-INFINITY;
    sel=0u;
    #pragma unroll
    for(int k=0;k<3;++k){ float bv=gv[0]; int bi=0;
      #pragma unroll
      for(int j=1;j<16;++j){ if(gv[j]>bv){bv=gv[j];bi=j;} }
      sel|=1u<<bi;
      #pragma unroll
      for(int j=0;j<16;++j) gv[j]=(j==bi)?-INFINITY:gv[j]; }
    asm volatile("s_waitcnt lgkmcnt(0)\n\ts_barrier":::"memory");
  }
  DMA_K(0,0);DMA_V(0,0);DMA_K(1,SLOTB);
  float mhat=0.f,l_reg=0.f;f32x16 o[2];o[0]=f32x16{};o[1]=f32x16{};const f32x16 zc=f32x16{};
  const int qrel=wid*QBLK+r32;
  #define BMASK(P0,P1,t) do{ if(!((sel>>((t)>>2))&1u)){ _Pragma("unroll") for(int r_=0;r_<16;++r_){P0[r_]=-INFINITY;P1[r_]=-INFINITY;} } }while(0)
  #define CMASK(P0,P1,t) do{int jb_=(t)-(NT-4); if(jb_>=0)cmask(P0,P1,jb_,qrel,hi); else BMASK(P0,P1,t);}while(0)
  bool resc=false;
  #define START(P0,P1) do{ const float rm=rowmax(P0,P1); resc=false; \
    if(__any(rm>(float)THRL)){ const float dl=__builtin_fmaxf(rm,0.f); mhat=fadd_s(mhat,dl); } \
    _Pragma("unroll") for(int r=0;r<16;++r)P0[r]=__builtin_amdgcn_exp2f(P0[r]-mhat); }while(0)
  #define RESC() do{ if(resc){ asm volatile("s_waitcnt lgkmcnt(0)":::"memory"); \
      _Pragma("unroll") for(int d_=0;d_<2;++d_) _Pragma("unroll") for(int r=0;r<16;++r)o[d_][r]*=wsf[crow(r,hi)]; } }while(0)
  f32x16 pA0,pA1,pB0,pB1;
  int sl_prev=0,sl_cur=0,sl_next=SLOTB;
  #define ROT() do{sl_prev=sl_cur;sl_cur=sl_next;sl_next=(sl_next==(NSLOT-1)*SLOTB)?0:sl_next+SLOTB;}while(0)
  DMA_K(2,2*SLOTB);
  WAIT_BAR(3);
  qkt(pA0,pA1,Kbase,qr,r32,hi);asm volatile("s_nop 15\n\ts_nop 7":"+v"(pA0),"+v"(pA1));CMASK(pA0,pA1,0);
  START(pA0,pA1);
  _Pragma("unroll") for(int r=0;r<16;++r)pA1[r]=__builtin_amdgcn_exp2f(pA1[r]-mhat);
  WAIT_BAR(0);
  DMA_K(3,0);DMA_V(1,SLOTB);
  ROT();
  kload8(kf,kp0+sl_cur);
  WAIT_BAR(2);
  s16x4 vlo[8],vhi[8]; u32x4 pw0,pw1,pw2,pw3;
  #define PKW(P,B) cvtpk_s(P[B],P[B+1])
  #define PAF(k) __builtin_bit_cast(bf16x8,pw##k)
  #define VFR(i) (bf16x8){vlo[i][0],vlo[i][1],vlo[i][2],vlo[i][3],vhi[i][0],vhi[i][1],vhi[i][2],vhi[i][3]}
  #define PIN(x) asm volatile("":"+v"(x))
  #define MX3(a,b,c) __builtin_fmaxf(__builtin_fmaxf((a),(b)),(c))
  #define GAPA(MF,A0,A1,A2,A3,W0,W1,PW) do{ MF; sacc+=A0; sacc+=A1; sacc+=A2; sacc+=A3; PIN(sacc); W0; W1; PIN(PW); SBAR(); }while(0)
  #define EX(v) __builtin_amdgcn_exp2f(v)
  #define GAPB(MF,X,B) do{ MF; X[B]=EX(X[B]-mhat); X[B+1]=EX(X[B+1]-mhat); X[B+2]=EX(X[B+2]-mhat); X[B+3]=EX(X[B+3]-mhat); PIN(X); SBAR(); }while(0)
  #define VRD(i) do{ vlo[i]=vtr(vp_+(((i)>>2)*4096+((i)&3)*1024)); vhi[i]=vtr(vp_+(((i)>>2)*4096+((i)&3)*1024+512)); }while(0)
  #define KRD(G,j) do{ if(G){ kload2(kf,kp0+sl_next,j); SBAR(); } }while(0)
  #define STEP(C0,C1,P0,P1,t,GK,GV,GL) do{ SBAR(); \
    const lds_cptr vp_=vp0+sl_prev; \
    VRD(0); SBAR(); float sacc=(P0[0]+P0[1]); \
    GAPA(C0=__builtin_amdgcn_mfma_f32_32x32x16_bf16(kf[0],qr[0],zc,0,0,0), P0[2],P0[3],P0[4],P0[5],     pw0[0]=PKW(P0,0), pw0[1]=PKW(P0,2), pw0); \
    VRD(4); SBAR(); GAPA(C1=__builtin_amdgcn_mfma_f32_32x32x16_bf16(kf[1],qr[0],zc,0,0,0), P0[6],P0[7],P0[8],P0[9],     pw0[2]=PKW(P0,4), pw0[3]=PKW(P0,6), pw0); \
    VRD(1); SBAR(); GAPA(C0=__builtin_amdgcn_mfma_f32_32x32x16_bf16(kf[2],qr[1],C0,0,0,0),   P0[10],P0[11],P0[12],P0[13], pw1[0]=PKW(P0,8), pw1[1]=PKW(P0,10), pw1); \
    VRD(5); SBAR(); GAPA(C1=__builtin_amdgcn_mfma_f32_32x32x16_bf16(kf[3],qr[1],C1,0,0,0),   P0[14],P0[15],P1[0],P1[1],   pw1[2]=PKW(P0,12),pw1[3]=PKW(P0,14), pw1); \
    VRD(2); SBAR(); GAPA(C0=__builtin_amdgcn_mfma_f32_32x32x16_bf16(kf[4],qr[2],C0,0,0,0),   P1[2],P1[3],P1[4],P1[5],     pw2[0]=PKW(P1,0), pw2[1]=PKW(P1,2), pw2); \
    VRD(6); SBAR(); GAPA(C1=__builtin_amdgcn_mfma_f32_32x32x16_bf16(kf[5],qr[2],C1,0,0,0),   P1[6],P1[7],P1[8],P1[9],     pw2[2]=PKW(P1,4), pw2[3]=PKW(P1,6), pw2); \
    VRD(3); SBAR(); GAPA(C0=__builtin_amdgcn_mfma_f32_32x32x16_bf16(kf[6],qr[3],C0,0,0,0),   P1[10],P1[11],P1[12],P1[13], pw3[0]=PKW(P1,8), pw3[1]=PKW(P1,10), pw3); \
    VRD(7); SBAR(); GAPA(C1=__builtin_amdgcn_mfma_f32_32x32x16_bf16(kf[7],qr[3],C1,0,0,0),   P1[14],P1[15],0.f,0.f,       pw3[2]=PKW(P1,12),pw3[3]=PKW(P1,14), pw3); \
    l_reg+=sacc; \
    if(GK){DMA_K((t)+3,sl_cur);} if(GV){DMA_V((t)+1,sl_next);} \
    CMASK(C0,C1,t); \
    { float a=MX3(C0[0],C0[1],C1[0]),b=MX3(C0[2],C0[3],C1[1]); a=MX3(a,C1[2],C1[3]); \
      _Pragma("unroll") for(int r=4;r<16;r+=4){a=MX3(a,C0[r],C0[r+1]);b=MX3(b,C0[r+2],C0[r+3]);a=MX3(a,C1[r],C1[r+1]);b=MX3(b,C1[r+2],C1[r+3]);} \
      float rm=__builtin_fmaxf(a,b); { auto rr=__builtin_amdgcn_permlane32_swap(__float_as_uint(rm),__float_as_uint(rm),false,false); rm=__builtin_fmaxf(__uint_as_float(rr[0]),__uint_as_float(rr[1])); } \
      resc=false; \
      if(__builtin_expect(__any(rm-mhat>(float)THRL),0)){ const float dl=__builtin_fmaxf(rm-mhat,0.f); mhat+=dl; \
        const float f=__builtin_amdgcn_exp2f(-dl); l_reg*=f; if(hi==0)wsf[r32]=f; resc=true; } } \
    SBAR(); \
    GAPB(o[0]=__builtin_amdgcn_mfma_f32_32x32x16_bf16(PAF(0),VFR(0),o[0],0,0,0), C0,0); \
    GAPB(o[1]=__builtin_amdgcn_mfma_f32_32x32x16_bf16(PAF(0),VFR(4),o[1],0,0,0), C0,4); \
    KRD(GL,0); GAPB(o[0]=__builtin_amdgcn_mfma_f32_32x32x16_bf16(PAF(1),VFR(1),o[0],0,0,0), C0,8); \
    KRD(GL,1); GAPB(o[1]=__builtin_amdgcn_mfma_f32_32x32x16_bf16(PAF(1),VFR(5),o[1],0,0,0), C0,12); \
    KRD(GL,2); GAPB(o[0]=__builtin_amdgcn_mfma_f32_32x32x16_bf16(PAF(2),VFR(2),o[0],0,0,0), C1,0); \
    KRD(GL,3); GAPB(o[1]=__builtin_amdgcn_mfma_f32_32x32x16_bf16(PAF(2),VFR(6),o[1],0,0,0), C1,4); \
    GAPB(o[0]=__builtin_amdgcn_mfma_f32_32x32x16_bf16(PAF(3),VFR(3),o[0],0,0,0), C1,8); \
    GAPB(o[1]=__builtin_amdgcn_mfma_f32_32x32x16_bf16(PAF(3),VFR(7),o[1],0,0,0), C1,12); \
    }while(0)
  int t=1;
  #undef CMASK
  #define CMASK(P0,P1,t) BMASK(P0,P1,t)
  for(;t+5<NT;t+=2){
    STEP(pB0,pB1,pA0,pA1,t,true,true,true);     WAIT_BAR(2); RESC(); ROT();
    STEP(pA0,pA1,pB0,pB1,t+1,true,true,true);   WAIT_BAR(2); RESC(); ROT();
  }
  #undef CMASK
  #define CMASK(P0,P1,t) do{int jb_=(t)-(NT-4); if(jb_>=0)cmask(P0,P1,jb_,qrel,hi); else BMASK(P0,P1,t);}while(0)
  #define ENDW(tt) do{ if((tt)+3<NT){WAIT_BAR(2);} else if((tt)+2<NT){WAIT_BAR(1);} else {WAIT_BAR(0);} }while(0)
  for(;t+1<NT;t+=2){
    STEP(pB0,pB1,pA0,pA1,t,(t+3<NT),(t+1<NT),(t+1<NT));       ENDW(t);   RESC(); ROT();
    STEP(pA0,pA1,pB0,pB1,t+1,(t+4<NT),(t+2<NT),(t+2<NT));     ENDW(t+1); RESC(); ROT();
  }
  STEP(pB0,pB1,pA0,pA1,NT-1,false,false,false); RESC();
  { float sacc=pB0[0]+pB0[1]; _Pragma("unroll") for(int r=2;r<16;++r)sacc+=pB0[r]; _Pragma("unroll") for(int r=0;r<16;++r)sacc+=pB1[r]; l_reg+=sacc;
    pw0=(u32x4){PKW(pB0,0),PKW(pB0,2),PKW(pB0,4),PKW(pB0,6)};pw1=(u32x4){PKW(pB0,8),PKW(pB0,10),PKW(pB0,12),PKW(pB0,14)};pw2=(u32x4){PKW(pB1,0),PKW(pB1,2),PKW(pB1,4),PKW(pB1,6)};pw3=(u32x4){PKW(pB1,8),PKW(pB1,10),PKW(pB1,12),PKW(pB1,14)};
    SBAR(); pv(o,vb0+sl_cur,PAF(0),PAF(1),PAF(2),PAF(3)); }
  #undef PKW
  #undef PAF
  #undef VFR
  #undef PIN
  #undef MX3
  #undef GAPA
  #undef GAPB
  #undef EX
  #undef VRD
  #undef KRD
  #undef STEP
  #undef ENDW
  {auto rr=__builtin_amdgcn_permlane32_swap(__float_as_uint(l_reg),__float_as_uint(l_reg),false,false);l_reg=__uint_as_float(rr[0])+__uint_as_float(rr[1]);}
  if(hi==0)wsf[32+r32]=l_reg;asm volatile("s_waitcnt lgkmcnt(0)":::"memory");
  float rli[16];
  #pragma unroll
  for(int r=0;r<16;++r)rli[r]=__builtin_amdgcn_rcpf(wsf[32+crow(r,hi)]);
  bf16*Ow=O+(rowbase+q0+wid*QBLK)*OP+h*D;
  { bf16*stg=(bf16*)(shm+LDS_OST)+wid*2048;
    #pragma unroll
    for(int r=0;r<16;++r){const int orow=crow(r,hi);
      #pragma unroll
      for(int d0=0;d0<2;++d0)stg[orow*64+d0*32+r32]=__float2bfloat16(o[d0][r]*rli[r]);}
    asm volatile("s_waitcnt lgkmcnt(0)":::"memory");
    #pragma unroll
    for(int i=0;i<4;++i){const int row=i*8+(lane>>3),ch=lane&7; const u32x4 v=*(const u32x4*)(stg+row*64+ch*8); ATTN_STORE16(Ow+(long)row*OP+ch*8,v);} }
  asm volatile("s_waitcnt lgkmcnt(0)\n\ts_barrier":::"memory");
  #undef DMA_K
  #undef DMA_V
  #undef CMASK
  #undef BMASK
  #undef START
  #undef RESC
  #undef ROT
}
constexpr int ATTN_LDS_BYTES=LDS_BYTES;
#undef SBAR
#undef WAIT_BAR
}

constexpr int NWAVES = 8, NTHR = NWAVES * 64;
constexpr int DMODEL = 1024, PB = 4, PS = 4096, MP = PB * PS  , SB = 32  , MPAD = 16640  ;
constexpr int NIN = 3592, NZ = 3584, FF = 4096, AH = 8, AD = 64, MH = 4, MD = 128, NCH = 64  , CH = 64, NPAGES = 64;
constexpr float RMS_EPS = 1e-6f;
constexpr float QK_SCALE_M = 0.08838834764831845f;
constexpr int N_PHASES = 9;
#ifndef PROBE_EXTRA_PHASE
#define PROBE_EXTRA_PHASE -1
#define PROBE_EXTRA_SUB 15
#define PROBE_EXTRA_PHASE2 -1
#endif
#ifndef MK_PER_PHASE
#define MK_PER_PHASE 0
#endif

constexpr size_t O_Y = 0, O_YS = 16777216, O_KP = 16809984, O_VP = 25198592, O_CP = 33587200, O_NP = 33849344, O_MPR = 33851392, O_KS = 33851408, O_VS = 33867792,
                 O_CS = 33884176, O_NS = 35981328, O_MS = 35997712, O_END = 35997840;

constexpr size_t MiB = 1u << 20;
constexpr size_t WS_CTL = 0, CTL_ZERO_BYTES = 1 * MiB;
constexpr size_t WS_KMP = 256 * 1024;
constexpr size_t WS_WIN = 2 * MiB, WS_WOUT = 10 * MiB, WS_WUP = 12 * MiB, WS_WDN = 20 * MiB;
constexpr size_t WS_GATES = 28 * MiB;
constexpr size_t WS_SSQ1 = 29 * MiB, WS_SSQ2 = 30 * MiB;
constexpr size_t WS_SMALL = 31 * MiB;
constexpr size_t SM_AB = 0;
constexpr size_t SM_MC = 16384;
constexpr size_t SM_DN = 32768;
constexpr size_t SM_NC = SM_DN + 524288;
constexpr size_t SM_KMB = SM_NC + 524288;
constexpr size_t SM_X1S = SM_KMB + 262144;
constexpr size_t SM_X2S = SM_X1S + 131072;
constexpr size_t SM_X1SB = SM_X2S + 131072;
constexpr size_t SM_US = SM_X1SB + 65536;
constexpr size_t SM_END = SM_US + 262144;
static_assert(SM_END <= 3 * MiB, "small tables");
constexpr size_t WS_KMS = 34 * MiB;
constexpr size_t WS_XN = 36 * MiB;
constexpr size_t WS_Z = 70 * MiB, Z_STRIDE_B = 17 * MiB;
constexpr size_t WS_MIX = 190 * MiB;
constexpr size_t WS_X1 = 224 * MiB;
constexpr size_t WS_X1B = 288 * MiB;
constexpr size_t WS_U = 320 * MiB;
constexpr size_t WS_DCT = 448 * MiB;
constexpr size_t WS_CT = 480 * MiB;
constexpr size_t WS_END = 512 * MiB;
static_assert(WS_WIN + (size_t)NZ * DMODEL * 2 <= WS_WOUT && WS_XN + (size_t)MPAD * DMODEL * 2 <= WS_Z && (size_t)MPAD * 512 * 2 <= Z_STRIDE_B && WS_Z + 7 * Z_STRIDE_B <= WS_MIX
              && WS_MIX + (size_t)MPAD * DMODEL * 2 <= WS_X1 && WS_GATES + (size_t)MPAD * 8 * 4 <= WS_SSQ1, "d_ws map");
constexpr int CW_TMO = 0, CW_CODE = 1;
constexpr int CW_BAR = 4096;

constexpr int RING_OFF = 0, RING_BYTES = 131072;
constexpr int LDSCTL_OFF = RING_BYTES, MISC_OFF = LDSCTL_OFF + 320;
constexpr int LDS_BYTES = 147456;
constexpr int ML_K = 0, ML_V = 16384, ML_Q = 32768, ML_C = 49152, ML_S = 81920, ML_SPITCH = 144, ML_VEC = 91136;

#define GAS __attribute__((address_space(1)))
#define LAS __attribute__((address_space(3)))
typedef unsigned short bf16;
typedef unsigned v4u __attribute__((ext_vector_type(4)));
typedef float f32x4 __attribute__((ext_vector_type(4)));
typedef short bf16x8 __attribute__((ext_vector_type(8)));
typedef GAS unsigned gu32;
typedef GAS unsigned long long gu64;
#define RLX_AGENT __ATOMIC_RELAXED, __HIP_MEMORY_SCOPE_AGENT
#define LDS_WAIT() asm volatile("s_waitcnt lgkmcnt(0)" ::: "memory")
#define VM_WAIT() asm volatile("s_waitcnt vmcnt(0)" ::: "memory")
__device__ __forceinline__ unsigned long long rt() { return __builtin_amdgcn_s_memrealtime(); }
__device__ __forceinline__ unsigned f2bf(float f) { unsigned u = __builtin_bit_cast(unsigned, f); return (u + 0x7fffu + ((u >> 16) & 1u)) >> 16; }
__device__ __forceinline__ unsigned pk2(float lo, float hi) { return f2bf(lo) | (f2bf(hi) << 16); }

#define XB_TMO      128
#define XB_XCNT(j)  (256  + 64 * (j))
#define XB_XSUB(j)  (1280 + 64 * (j))
#define XB_XGEN(j)  (2304 + 64 * (j))
#define XB_TOP      3328
#define XB_TOPGEN   3392
#define XCD_BAR_WORDS 3456
#define XB_SPIN_CAP (1u << 18)

__device__ __forceinline__ unsigned xb_ld(unsigned* p)              { return __hip_atomic_load(p, __ATOMIC_RELAXED, __HIP_MEMORY_SCOPE_AGENT); }
__device__ __forceinline__ unsigned xb_add(unsigned* p, unsigned v) { return __hip_atomic_fetch_add(p, v, __ATOMIC_RELAXED, __HIP_MEMORY_SCOPE_AGENT); }
__device__ __forceinline__ unsigned xb_xcc_id() { return (unsigned)__builtin_amdgcn_s_getreg((3 << 11) | 20) & 0xFu; }
#define XB_SPIN(cond, bar) do { unsigned _sp = 0; while (cond) { __builtin_amdgcn_s_sleep(1); \
    if ((++_sp & 255u) == 0u) { if (xb_ld(&(bar)[XB_TMO])) break; if (_sp > XB_SPIN_CAP) { atomicAdd(&(bar)[XB_TMO], 1u); break; } } } } while (0)

struct XcdBarrier {
    unsigned* bar; unsigned x;
    volatile LAS unsigned* st;
};

__device__ __forceinline__ XcdBarrier xcd_barrier_post(unsigned* bar, volatile LAS unsigned* st) {
    XcdBarrier b; b.bar = bar; b.x = xb_xcc_id(); b.st = st;
    if (threadIdx.x == 0) (void)xb_add(&bar[XB_XCNT(b.x)], 1u);
    return b;
}
__device__ __forceinline__ void xcd_barrier_complete(unsigned* bar, unsigned x, unsigned& nloc, unsigned& nx) {
    const unsigned G = gridDim.x * gridDim.y * gridDim.z;
    unsigned sum, cnt, mine, sp = 0u;
    for (;;) {
        sum = 0u; cnt = 0u; mine = 0u;
#pragma unroll
        for (unsigned j = 0; j < 16; ++j) { const unsigned c = xb_ld(&bar[XB_XCNT(j)]); sum += c; cnt += (c > 0u) ? 1u : 0u; mine = (j == x) ? c : mine; }
        if (sum == G) break;
        __builtin_amdgcn_s_sleep(1);
        if ((++sp & 255u) == 0u) { if (xb_ld(&bar[XB_TMO])) break; if (sp > XB_SPIN_CAP) { atomicAdd(&bar[XB_TMO], 1u); break; } }
    }
    nloc = mine > 0u ? mine : 1u; nx = cnt > 0u ? cnt : 1u;
}

__device__ __forceinline__ void xcd_barrier(const XcdBarrier& b) {
    asm volatile("s_waitcnt vmcnt(0)" ::: "memory");
    __syncthreads();
    if (threadIdx.x == 0) {
        unsigned* bar = b.bar;
        __builtin_amdgcn_s_waitcnt(0);
        unsigned nloc = b.st[0], nx = b.st[1];
        if (nloc == 0u) { xcd_barrier_complete(bar, b.x, nloc, nx); b.st[0] = nloc; b.st[1] = nx; }
        const unsigned old = xb_add(&bar[XB_XSUB(b.x)], 1u);
        const unsigned gen = old / nloc;
        if (old + 1u == (gen + 1u) * nloc) {
            __builtin_amdgcn_fence(__ATOMIC_RELEASE, "agent");
            asm volatile("s_waitcnt vmcnt(0)" ::: "memory");
            const unsigned og = xb_add(&bar[XB_TOP], 1u);
            const unsigned tg = og / nx;
            if (og + 1u == (tg + 1u) * nx) xb_add(&bar[XB_TOPGEN], 1u);
            else XB_SPIN(xb_ld(&bar[XB_TOPGEN]) == tg, bar);
            __builtin_amdgcn_fence(__ATOMIC_ACQUIRE, "agent");
            xb_add(&bar[XB_XGEN(b.x)], 1u);
            asm volatile("s_waitcnt vmcnt(0)" ::: "memory");
        } else {
            XB_SPIN(xb_ld(&bar[XB_XGEN(b.x)]) == gen, bar);
            __builtin_amdgcn_fence(__ATOMIC_ACQUIRE, "agent");
            asm volatile("s_waitcnt vmcnt(0)" ::: "memory");
        }
    }
    __syncthreads();
}

typedef float f32x2 __attribute__((ext_vector_type(2)));
typedef unsigned u32x2 __attribute__((ext_vector_type(2)));
typedef short v4i16_t __attribute__((ext_vector_type(4)));
struct Args { const void* in[17]; float* out; unsigned char* ws; int ph_lo, ph_hi, sub, pad; };

__device__ __forceinline__ float bf2f(bf16 v) { return __uint_as_float((unsigned)v << 16); }
__device__ __forceinline__ float bflo(unsigned w) { return __uint_as_float(w << 16); }
__device__ __forceinline__ float bfhi(unsigned w) { return __uint_as_float(w & 0xffff0000u); }
__device__ __forceinline__ float wave_sum(float v) {
#pragma unroll
    for (int o = 1; o < 64; o <<= 1) v += __shfl_xor(v, o);
    return v;
}
__device__ __forceinline__ float wave_max(float v) {
#pragma unroll
    for (int o = 1; o < 64; o <<= 1) v = fmaxf(v, __shfl_xor(v, o));
    return v;
}
__device__ __forceinline__ float log_sigmoid(float x) { return fminf(x, 0.f) - log1pf(expf(-fabsf(x))); }
__device__ __forceinline__ float sigmoidf(float x) { return 1.0f / (1.0f + expf(-x)); }
__device__ __forceinline__ f32x4 mfma16(bf16x8 a, bf16x8 b, f32x4 c) { return __builtin_amdgcn_mfma_f32_16x16x32_bf16(a, b, c, 0, 0, 0); }

__device__ __forceinline__ unsigned off_b(unsigned row, unsigned ch) { return 256u * row + 16u * (ch ^ (((row & 3) << 2) | ((row >> 2) & 3))); }
__device__ __forceinline__ bf16x8 img_row_frag(const LAS unsigned char* img, unsigned lane, unsigned rb, unsigned s) { return *(const LAS bf16x8*)(img + off_b((lane & 15) + 16 * rb, 4 * s + (lane >> 4))); }
__device__ __forceinline__ bf16x8 img_tr_frag(const LAS unsigned char* img, unsigned lane, unsigned c, unsigned ks) {
    const unsigned g = lane >> 4, q = (lane & 15) >> 2, p = lane & 3;
    const v4i16_t lo = __builtin_amdgcn_ds_read_tr16_b64_v4i16((LAS v4i16_t*)(img + off_b(32 * ks + 8 * g + q, 2 * c + (p >> 1)) + 8 * (p & 1)));
    const v4i16_t hi = __builtin_amdgcn_ds_read_tr16_b64_v4i16((LAS v4i16_t*)(img + off_b(32 * ks + 8 * g + 4 + q, 2 * c + (p >> 1)) + 8 * (p & 1)));
    return (bf16x8){lo[0], lo[1], lo[2], lo[3], hi[0], hi[1], hi[2], hi[3]};
}
template <int N> __device__ __forceinline__ void img_fetch(v4u (&r)[N], const bf16* src, size_t pitch, int tid) {
#pragma unroll
    for (int i = 0; i < N; ++i) { const int n = tid + NTHR * i; r[i] = *(const v4u*)(src + (size_t)(n >> 4) * pitch + (n & 15) * 8); }
}
template <int N> __device__ __forceinline__ void img_store(LAS unsigned char* img, const v4u (&r)[N], int tid) {
#pragma unroll
    for (int i = 0; i < N; ++i) { const int n = tid + NTHR * i; *(LAS v4u*)(img + off_b(n >> 4, n & 15)) = r[i]; }
}

__device__ __forceinline__ void p0_transpose_item(const float* W, int K, int Nsrc, int nblk, bf16* WT, const float* kscale, LAS float* scr, int item, int lane) {
    const int kb = item / nblk, nb = item % nblk, k0 = 64 * kb, n0 = 32 * nb;
#pragma unroll 8
    for (int i = 0; i < 32; ++i) { const int kk = 2 * i + (lane >> 5); float v = W[(size_t)(k0 + kk) * Nsrc + n0 + (lane & 31)]; if (kscale) v *= kscale[k0 + kk]; scr[kk * 33 + (lane & 31)] = v; }
    LDS_WAIT(); asm volatile("" ::: "memory");
    const int c = lane & 7;
#pragma unroll
    for (int j = 0; j < 4; ++j) { const int n = (lane >> 3) + 8 * j; const LAS float* s = scr + (8 * c) * 33 + n;
        v4u o; o.x = pk2(s[0 * 33], s[1 * 33]); o.y = pk2(s[2 * 33], s[3 * 33]); o.z = pk2(s[4 * 33], s[5 * 33]); o.w = pk2(s[6 * 33], s[7 * 33]);
        *(GAS v4u*)(WT + (size_t)(n0 + n) * K + k0 + 8 * c) = o; }
    LDS_WAIT(); asm volatile("" ::: "memory");
}
__device__ __forceinline__ void p0_rows(const Args& a, bf16* XN, float* GATES, int gw, int NGW, int lane) {
    const float* x = (const float*)a.in[0]; const float* xs = (const float*)a.in[1]; const float* ln1 = (const float*)a.in[8]; const float* w_in = (const float*)a.in[9]; const float* bg = (const float*)a.in[10];
    f32x4 lw[4], wg[4][4][2];
#pragma unroll
    for (int j = 0; j < 4; ++j) { lw[j] = *(const f32x4*)(ln1 + 4 * lane + 256 * j);
#pragma unroll
        for (int i = 0; i < 4; ++i) { const float* p = w_in + (size_t)(4 * lane + 256 * j + i) * NIN + NZ; wg[j][i][0] = *(const f32x4*)p; wg[j][i][1] = *(const f32x4*)(p + 4); } }
    for (int m = gw; m < MP + SB; m += NGW) {
        const float* xrow = (m < MP) ? x + (size_t)m * DMODEL : xs + (size_t)(m - MP) * DMODEL;
        const GAS f32x4* xr = (const GAS f32x4*)xrow + lane;
        f32x4 v[4]; float s = 0.f;
#pragma unroll
        for (int j = 0; j < 4; ++j) { v[j] = xr[64 * j]; s += (v[j].x * v[j].x + v[j].y * v[j].y) + (v[j].z * v[j].z + v[j].w * v[j].w); }
        const float rs = 1.0f / sqrtf(wave_sum(s) * (1.0f / DMODEL) + RMS_EPS);
        f32x4 g0 = {0.f, 0.f, 0.f, 0.f}, g1 = {0.f, 0.f, 0.f, 0.f};
        GAS unsigned long long* o8 = (GAS unsigned long long*)(XN + (size_t)m * DMODEL) + lane;
#pragma unroll
        for (int j = 0; j < 4; ++j) { const f32x4 y = v[j] * rs * lw[j];
            o8[64 * j] = (unsigned long long)pk2(y.x, y.y) | ((unsigned long long)pk2(y.z, y.w) << 32);
#pragma unroll
            for (int i = 0; i < 4; ++i) { g0 += wg[j][i][0] * y[i]; g1 += wg[j][i][1] * y[i]; } }
#pragma unroll
        for (int i = 0; i < 4; ++i) { g0[i] = wave_sum(g0[i]); g1[i] = wave_sum(g1[i]); }
        if (lane == 0) { *(f32x4*)(GATES + (size_t)m * 8) = g0 + *(const f32x4*)bg; *(f32x4*)(GATES + (size_t)m * 8 + 4) = g1 + *(const f32x4*)(bg + 4); }
    }
}
__device__ __forceinline__ void p0_kmean_unit(const float* cache_k, const int* page_table, float* kms, int unit, LAS float* scr, int tid) {
    const int b = unit >> 5, j = unit & 31, rg = tid >> 7, c4 = tid & 127;
    const int page = page_table[b * NPAGES + 2 * j + (rg >> 1)];
    const f32x4* src = (const f32x4*)(cache_k + ((size_t)page * 128 + (rg & 1) * 64) * 512) + c4;
    f32x4 s = {0.f, 0.f, 0.f, 0.f};
#pragma unroll 16
    for (int r = 0; r < 64; ++r) s += __builtin_nontemporal_load(src + r * 128);
    *(LAS f32x4*)(scr + (rg * 128 + c4) * 4) = s;
    __syncthreads();
    if (tid < 128) { const f32x4 t = (*(LAS f32x4*)(scr + tid * 4) + *(LAS f32x4*)(scr + (128 + tid) * 4)) + (*(LAS f32x4*)(scr + (256 + tid) * 4) + *(LAS f32x4*)(scr + (384 + tid) * 4));
        *(f32x4*)(kms + (size_t)unit * 512 + tid * 4) = t * (1.0f / 256.0f); }
    __syncthreads();
}

__device__ __forceinline__ void ml_local_unit(unsigned char* ws, LAS unsigned char* lds, int u, int tid) {
    const int lane = tid & 63, wid = __builtin_amdgcn_readfirstlane(tid >> 6);
    const int bh = u >> 6, c = u & 63, b = bh >> 2, h = bh & 3; const size_t rowbase = (size_t)b * PS + c * CH;
    const float* GATES = (const float*)(ws + WS_GATES);
    const bf16* KM = (const bf16*)(ws + WS_Z + 4 * Z_STRIDE_B); const bf16* VM = (const bf16*)(ws + WS_Z + 5 * Z_STRIDE_B);
    LAS float* vec = (LAS float*)(lds + ML_VEC);
    v4u rk[2], rv[2];
    img_fetch<2>(rk, KM + rowbase * 512 + h * MD, 512, tid); img_fetch<2>(rv, VM + rowbase * 512 + h * MD, 512, tid);
    if (wid == 0) {
        const float gi = GATES[(rowbase + lane) * 8 + h], gf = GATES[(rowbase + lane) * 8 + 4 + h];
        float bc = log_sigmoid(gf);
#pragma unroll
        for (int o = 1; o < 64; o <<= 1) { const float t = __shfl_up(bc, o); if (lane >= o) bc += t; }
        const float B = __shfl(bc, 63), val = B - bc + gi, amax = wave_max(val);
        vec[lane] = expf(val - amax);
        if (lane == 0) { float* AB = (float*)(ws + WS_SMALL + SM_AB) + (size_t)u * 2; AB[0] = amax; AB[1] = B; }
    }
    __syncthreads();
#pragma unroll
    for (int i = 0; i < 2; ++i) { const int n = tid + NTHR * i, row = n >> 4, ch = n & 15; const v4u kv = rk[i]; const float w = vec[row]; v4u o;
        o.x = pk2(bflo(kv.x) * w, bfhi(kv.x) * w); o.y = pk2(bflo(kv.y) * w, bfhi(kv.y) * w); o.z = pk2(bflo(kv.z) * w, bfhi(kv.z) * w); o.w = pk2(bflo(kv.w) * w, bfhi(kv.w) * w);
        *(LAS v4u*)(lds + ML_K + off_b(row, ch)) = o; }
    img_store<2>(lds + ML_V, rv, tid);
    __syncthreads();
    {
        const bf16x8 vb0 = img_tr_frag(lds + ML_V, lane, wid, 0), vb1 = img_tr_frag(lds + ML_V, lane, wid, 1);
        bf16* DCT = (bf16*)(ws + WS_DCT) + (size_t)u * 16384 + (size_t)(16 * wid + (lane & 15)) * 128 + 4 * (lane >> 4);
#pragma unroll
        for (int dt = 0; dt < 8; ++dt) { f32x4 acc = {0.f, 0.f, 0.f, 0.f};
            acc = mfma16(img_tr_frag(lds + ML_K, lane, dt, 0), vb0, acc); acc = mfma16(img_tr_frag(lds + ML_K, lane, dt, 1), vb1, acc);
            u32x2 w; w.x = pk2(acc[0], acc[1]); w.y = pk2(acc[2], acc[3]); *(u32x2*)(DCT + 16 * dt) = w; }
    }
    if (tid < 128) { float s = 0.f;
#pragma unroll 8
        for (int r = 0; r < CH; ++r) s += bf2f(*(const LAS bf16*)(lds + ML_K + off_b(r, tid >> 3) + 2 * (tid & 7)));
        ((float*)(ws + WS_SMALL + SM_DN))[(size_t)u * 128 + tid] = s; }
    __syncthreads();
}

__device__ __forceinline__ void ml_scan_unit(const Args& a, LAS unsigned char* lds, int u, int tid) {
    unsigned char* ws = a.ws; const int bh = u >> 4, sl = u & 15;
    LAS float* tA = (LAS float*)(lds + ML_VEC); LAS float* tB = tA + 64; LAS float* dA = tA + 128; LAS float* dB = tA + 192; LAS float* mfin = tA + 256;
    if (tid < 64) { const float* AB = (const float*)(ws + WS_SMALL + SM_AB) + ((size_t)bh * 64 + tid) * 2; tA[tid] = AB[0]; tB[tid] = AB[1]; }
    __syncthreads();
    if (tid == 0) { float m = 0.f; float* MC = (float*)(ws + WS_SMALL + SM_MC) + (size_t)bh * 64;
        for (int c = 0; c < NCH; ++c) { const float mn = fmaxf(tB[c] + m, tA[c]); dA[c] = expf(tB[c] + m - mn); dB[c] = expf(tA[c] - mn); if (sl == 0) MC[c] = m; m = mn; }
        mfin[0] = m; }
    __syncthreads();
    const int e = sl * 8 + (tid >> 6), d = 2 * (tid & 63);
    const unsigned* src = (const unsigned*)((const bf16*)(ws + WS_DCT) + ((size_t)bh * 64 * 128 + e) * 128 + d);
    unsigned* dst = (unsigned*)((bf16*)(ws + WS_CT) + ((size_t)bh * 64 * 128 + e) * 128 + d);
    float c0 = 0.f, c1 = 0.f;
#pragma unroll 8
    for (int c = 0; c < NCH; ++c) { dst[(size_t)c * 8192] = pk2(c0, c1); const unsigned x = src[(size_t)c * 8192]; const float fa = dA[c], fb = dB[c]; c0 = fa * c0 + fb * bflo(x); c1 = fa * c1 + fb * bfhi(x); }
    float* CP = a.out + O_CP + (size_t)bh * 16384; CP[(size_t)d * 128 + e] = c0; CP[(size_t)(d + 1) * 128 + e] = c1;
    if (sl == 0 && tid < 128) { const float* DN = (const float*)(ws + WS_SMALL + SM_DN) + (size_t)bh * 64 * 128 + tid; float* NC = (float*)(ws + WS_SMALL + SM_NC) + (size_t)bh * 64 * 128 + tid; float n = 0.f;
#pragma unroll 8
        for (int c = 0; c < NCH; ++c) { NC[c * 128] = n; n = dA[c] * n + dB[c] * DN[c * 128]; }
        a.out[O_NP + bh * 128 + tid] = n; }
    if (sl == 0 && tid == 0) a.out[O_MPR + bh] = mfin[0];
    __syncthreads();
}

__device__ __forceinline__ void ml_out_unit(const Args& a, LAS unsigned char* lds, int u, int tid) {
    unsigned char* ws = a.ws; const int lane = tid & 63, wid = __builtin_amdgcn_readfirstlane(tid >> 6);
    const int bh = u >> 6, c = u & 63, b = bh >> 2, h = bh & 3; const size_t rowbase = (size_t)b * PS + c * CH;
    const float* GATES = (const float*)(ws + WS_GATES);
    const bf16* QM = (const bf16*)(ws + WS_Z + 3 * Z_STRIDE_B); const bf16* KM = (const bf16*)(ws + WS_Z + 4 * Z_STRIDE_B); const bf16* VM = (const bf16*)(ws + WS_Z + 5 * Z_STRIDE_B); const bf16* OM = (const bf16*)(ws + WS_Z + 6 * Z_STRIDE_B);
    LAS float* vec = (LAS float*)(lds + ML_VEC);
    LAS float* vg = vec, *vG = vec + 64, *vdec = vec + 128, *vfloor = vec + 192, *vrow = vec + 256, *vqn = vec + 320, *vpart = vec + 384  , *vn = vec + 512  ;
    v4u rq[2], rk[2], rv[2], rc[4];
    img_fetch<2>(rq, QM + rowbase * 512 + h * MD, 512, tid); img_fetch<2>(rk, KM + rowbase * 512 + h * MD, 512, tid); img_fetch<2>(rv, VM + rowbase * 512 + h * MD, 512, tid);
    img_fetch<4>(rc, (const bf16*)(ws + WS_CT) + (size_t)u * 16384, 128, tid);
    if (wid == 0) {
        const float gi = GATES[(rowbase + lane) * 8 + h], gf = GATES[(rowbase + lane) * 8 + 4 + h];
        const float mc = ((const float*)(ws + WS_SMALL + SM_MC))[u];
        float bc = log_sigmoid(gf);
#pragma unroll
        for (int o = 1; o < 64; o <<= 1) { const float t = __shfl_up(bc, o); if (lane >= o) bc += t; }
        const float g = gi - bc; float gm = g;
#pragma unroll
        for (int o = 1; o < 64; o <<= 1) { const float t = __shfl_up(gm, o); if (lane >= o) gm = fmaxf(gm, t); }
        const float G = fmaxf(mc, gm);
        vg[lane] = g; vG[lane] = G; vdec[lane] = expf(mc - G) * QK_SCALE_M; vfloor[lane] = expf(-(bc + G));
    }
    if (tid >= 64 && tid < 192) vn[tid - 64] = ((const float*)(ws + WS_SMALL + SM_NC))[(size_t)u * 128 + (tid - 64)];
    img_store<2>(lds + ML_Q, rq, tid); img_store<2>(lds + ML_K, rk, tid); img_store<2>(lds + ML_V, rv, tid); img_store<4>(lds + ML_C, rc, tid);
    __syncthreads();
    const int tt = wid & 3;
    u32x2 omw[4];
#pragma unroll
    for (int i = 0; i < 4; ++i) omw[i] = *(const u32x2*)(OM + (rowbase + 16 * tt + (lane & 15)) * 512 + h * MD + 16 * (4 * (wid >> 2) + i) + 4 * (lane >> 4));
    {
        const int t = 16 * tt + (lane & 15); const float Gt = vG[t];
#pragma unroll
        for (int i = 0; i < 2; ++i) { const int st = 2 * (wid >> 2) + i; f32x4 acc = {0.f, 0.f, 0.f, 0.f};
            if (st <= tt) {
#pragma unroll
                for (int kk = 0; kk < 4; ++kk) acc = mfma16(img_row_frag(lds + ML_K, lane, st, kk), img_row_frag(lds + ML_Q, lane, tt, kk), acc); }
            const int s0 = 16 * st + 4 * (lane >> 4); float p[4];
#pragma unroll
            for (int r = 0; r < 4; ++r) { const int s = s0 + r; p[r] = (s <= t) ? acc[r] * QK_SCALE_M * expf(vg[s] - Gt) : 0.f; }
            u32x2 w; w.x = pk2(p[0], p[1]); w.y = pk2(p[2], p[3]); *(LAS u32x2*)(lds + ML_S + t * ML_SPITCH + s0 * 2) = w; }
    }
    __syncthreads();
    if (tid < 64) { float s = 0.f; const LAS unsigned* rp = (const LAS unsigned*)(lds + ML_S + tid * ML_SPITCH);
#pragma unroll 8
        for (int j = 0; j < 32; ++j) { const unsigned x = rp[j]; s += bflo(x) + bfhi(x); }
        vrow[tid] = s; }
    else if (tid < 128) { const int t = tid - 64; float s = 0.f;
#pragma unroll 4
        for (int ch = 0; ch < 16; ++ch) { const v4u q = *(const LAS v4u*)(lds + ML_Q + off_b(t, ch)); const LAS float* np = vn + ch * 8;
            s += bflo(q.x) * np[0] + bfhi(q.x) * np[1] + bflo(q.y) * np[2] + bfhi(q.y) * np[3] + bflo(q.z) * np[4] + bfhi(q.z) * np[5] + bflo(q.w) * np[6] + bfhi(q.w) * np[7]; }
        vqn[t] = s; }
    f32x4 acc1[4], acc2[4];
    {
        bf16x8 sb[2], qb[4];
#pragma unroll
        for (int ks = 0; ks < 2; ++ks) sb[ks] = *(const LAS bf16x8*)(lds + ML_S + (16 * tt + (lane & 15)) * ML_SPITCH + (32 * ks + 8 * (lane >> 4)) * 2);
#pragma unroll
        for (int kk = 0; kk < 4; ++kk) qb[kk] = img_row_frag(lds + ML_Q, lane, tt, kk);
#pragma unroll
        for (int i = 0; i < 4; ++i) { const int et = 4 * (wid >> 2) + i; f32x4 x = {0.f, 0.f, 0.f, 0.f}, y = {0.f, 0.f, 0.f, 0.f};
#pragma unroll
            for (int ks = 0; ks < 2; ++ks) x = mfma16(img_tr_frag(lds + ML_V, lane, et, ks), sb[ks], x);
#pragma unroll
            for (int kk = 0; kk < 4; ++kk) y = mfma16(img_row_frag(lds + ML_C, lane, et, kk), qb[kk], y);
            acc1[i] = x; acc2[i] = y; }
    }
    __syncthreads();
    const int t = 16 * tt + (lane & 15);
    const float dec = vdec[t], den = vrow[t] + dec * vqn[t], inv = 1.0f / fmaxf(fabsf(den), vfloor[t]);
    float ss = 0.f;
#pragma unroll
    for (int i = 0; i < 4; ++i) { acc1[i] = (acc1[i] + acc2[i] * dec) * inv; ss += (acc1[i][0] * acc1[i][0] + acc1[i][1] * acc1[i][1]) + (acc1[i][2] * acc1[i][2] + acc1[i][3] * acc1[i][3]); }
    ss += __shfl_xor(ss, 16); ss += __shfl_xor(ss, 32);
    if (lane < 16) vpart[(wid >> 2) * 64 + t] = ss;
    __syncthreads();
    const float rs = 1.0f / sqrtf((vpart[t] + vpart[64 + t]) * (1.0f / MD) + RMS_EPS);
    const float* nw = (const float*)a.in[11] + h * MD;
    bf16* MIX = (bf16*)(ws + WS_MIX);
#pragma unroll
    for (int i = 0; i < 4; ++i) { const int e0 = 16 * (4 * (wid >> 2) + i) + 4 * (lane >> 4);
        const u32x2 ow = omw[i]; const f32x4 g = *(const f32x4*)(nw + e0);
        const float o0 = acc1[i][0] * rs * g[0] * sigmoidf(bflo(ow.x)), o1 = acc1[i][1] * rs * g[1] * sigmoidf(bfhi(ow.x)), o2 = acc1[i][2] * rs * g[2] * sigmoidf(bflo(ow.y)), o3 = acc1[i][3] * rs * g[3] * sigmoidf(bfhi(ow.y));
        u32x2 w; w.x = pk2(o0, o1); w.y = pk2(o2, o3); *(u32x2*)(MIX + (rowbase + t) * DMODEL + 512 + h * MD + e0) = w; }
    __syncthreads();
}

__device__ __forceinline__ void dec_attn_unit(const Args& a, LAS unsigned char* lds, int u, int tid) {
    unsigned char* ws = a.ws; const int lane = tid & 63, wid = __builtin_amdgcn_readfirstlane(tid >> 6); const int b = u >> 3, h = u & 7;
    const float* cache_k = (const float*)a.in[2]; const float* cache_v = (const float*)a.in[3]; const int* pt = (const int*)a.in[4] + b * NPAGES;
    LAS float* sc = (LAS float*)lds; LAS float* red = sc + 1024; LAS int* seli = (LAS int*)(red + 2048); LAS float* misc = (LAS float*)(seli + 8);
    const bf16* qrow = (const bf16*)(ws + WS_Z) + (size_t)(MP + b) * 512 + h * AD;
    if (wid == 0) {
        const int j = lane & 31; const float* km = (const float*)(ws + WS_KMS) + ((size_t)(b * 32 + j)) * 512 + h * AD; float g = 0.f;
#pragma unroll 8
        for (int d = 0; d < AD; ++d) g += bf2f(qrow[d]) * km[d];
#pragma unroll
        for (int k = 0; k < 3; ++k) { float bv = g; int bi = j;
#pragma unroll
            for (int o = 16; o >= 1; o >>= 1) { const float ov = __shfl_xor(bv, o); const int oi = __shfl_xor(bi, o); if (ov > bv || (ov == bv && oi < bi)) { bv = ov; bi = oi; } }
            if (lane == 0) seli[k] = bi; if (j == bi) g = -INFINITY; }
    }
    __syncthreads();
    const int sub = lane & 15;
    int pg[6];
#pragma unroll
    for (int k = 0; k < 3; ++k) { const int blk = __builtin_amdgcn_readfirstlane(seli[k]); pg[2 * k] = pt[2 * blk]; pg[2 * k + 1] = pt[2 * blk + 1]; }
    f32x4 q4; { const u32x2 qw = *(const u32x2*)(qrow + 4 * sub); q4 = (f32x4){bflo(qw.x), bfhi(qw.x), bflo(qw.y), bfhi(qw.y)}; }
    {
        f32x4 kv[24];
#pragma unroll
        for (int it = 0; it < 24; ++it) { const int page = pg[2 * (it >> 3) + ((it & 7) >> 2)], slot = 32 * (it & 3) + wid * 4 + (lane >> 4);
            kv[it] = __builtin_nontemporal_load((const f32x4*)(cache_k + (((size_t)page * 128 + slot) * AH + h) * AD) + sub); }
#pragma unroll
        for (int it = 0; it < 24; ++it) { float dsum = (q4[0] * kv[it][0] + q4[1] * kv[it][1]) + (q4[2] * kv[it][2] + q4[3] * kv[it][3]);
            dsum += __shfl_xor(dsum, 1); dsum += __shfl_xor(dsum, 2); dsum += __shfl_xor(dsum, 4); dsum += __shfl_xor(dsum, 8);
            if (sub == 0) sc[it * 32 + wid * 4 + (lane >> 4)] = dsum; }
    }
    if (wid == 0) { const f32x4 kv = *(const f32x4*)(a.out + O_KS + (size_t)b * 512 + h * AD + 4 * sub);
        float dsum = (q4[0] * kv[0] + q4[1] * kv[1]) + (q4[2] * kv[2] + q4[3] * kv[3]);
        dsum += __shfl_xor(dsum, 1); dsum += __shfl_xor(dsum, 2); dsum += __shfl_xor(dsum, 4); dsum += __shfl_xor(dsum, 8);
        if (lane == 0) sc[768] = dsum; }
    __syncthreads();
    if (wid == 0) { float m = -INFINITY;
        for (int i = lane; i < 769; i += 64) m = fmaxf(m, sc[i]);
        m = wave_max(m); float l = 0.f;
        for (int i = lane; i < 769; i += 64) { const float p = exp2f(sc[i] - m); sc[i] = p; l += p; }
        l = wave_sum(l); if (lane == 0) misc[0] = 1.0f / l; }
    __syncthreads();
    { const int g = tid >> 4; f32x4 acc = {0.f, 0.f, 0.f, 0.f};
        f32x4 vv[24];
#pragma unroll
        for (int i = 0; i < 24; ++i) { const int page = pg[2 * (i >> 3) + ((i & 7) >> 2)], slot = g + 32 * (i & 3);
            vv[i] = __builtin_nontemporal_load((const f32x4*)(cache_v + (((size_t)page * 128 + slot) * AH + h) * AD) + sub); }
#pragma unroll
        for (int i = 0; i < 24; ++i) acc += vv[i] * sc[g + 32 * i];
        *(LAS f32x4*)(red + g * 64 + 4 * sub) = acc; }
    __syncthreads();
    if (tid < 64) { float o = 0.f;
#pragma unroll 8
        for (int g = 0; g < 32; ++g) o += red[g * 64 + tid];
        o += sc[768] * a.out[O_VS + (size_t)b * 512 + h * AD + tid];
        ((bf16*)(ws + WS_MIX))[(size_t)(MP + b) * DMODEL + h * AD + tid] = (bf16)f2bf(o * misc[0]); }
    __syncthreads();
}

__device__ __forceinline__ void dec_mlstm_unit(const Args& a, LAS unsigned char* lds, int u, int tid) {
    unsigned char* ws = a.ws; const int b = u >> 2, h = u & 3; const size_t row = MP + b;
    const bf16* QM = (const bf16*)(ws + WS_Z + 3 * Z_STRIDE_B) + row * 512 + h * MD; const bf16* KM = (const bf16*)(ws + WS_Z + 4 * Z_STRIDE_B) + row * 512 + h * MD;
    const bf16* VM = (const bf16*)(ws + WS_Z + 5 * Z_STRIDE_B) + row * 512 + h * MD; const bf16* OM = (const bf16*)(ws + WS_Z + 6 * Z_STRIDE_B) + row * 512 + h * MD;
    const float* GATES = (const float*)(ws + WS_GATES) + row * 8;
    const float* C0 = (const float*)a.in[5] + (size_t)u * 16384; const float* n0 = (const float*)a.in[6] + (size_t)u * 128; const float m0 = ((const float*)a.in[7])[u];
    LAS float* sq = (LAS float*)lds; LAS float* sk = sq + 128; LAS float* part = sk + 128  ; LAS float* sred = part + 512  ;
    const float gi = GATES[h], lf = log_sigmoid(GATES[4 + h]);
    const float mt = fmaxf(lf + m0, gi), wd = expf(gi - mt), dec = expf(lf + m0 - mt);
    if (tid < 128) { const float q = bf2f(QM[tid]), k = bf2f(KM[tid]); sq[tid] = q; sk[tid] = k;
        float qk = q * k, qn = q * n0[tid]; qk = wave_sum(qk); qn = wave_sum(qn);
        if ((tid & 63) == 0) { sred[tid >> 6] = qk; sred[2 + (tid >> 6)] = qn; }
        a.out[O_NS + (size_t)u * 128 + tid] = dec * n0[tid] + wd * k; }
    __syncthreads();
    const int e = tid & 127, dg = tid >> 7; const float v = bf2f(VM[e]);
    float* Cn = a.out + O_CS + (size_t)u * 16384; float acc = 0.f;
#pragma unroll 8
    for (int i = 0; i < 32; ++i) { const int d = dg * 32 + i; const float c0 = C0[(size_t)d * 128 + e]; acc += sq[d] * c0; Cn[(size_t)d * 128 + e] = dec * c0 + wd * sk[d] * v; }
    part[dg * 128 + e] = acc;
    __syncthreads();
    float hval = 0.f;
    if (tid < 128) { const float qk = (sred[0] + sred[1]) * QK_SCALE_M * wd, qn = (sred[2] + sred[3]) * QK_SCALE_M;
        const float num = qk * v + dec * QK_SCALE_M * ((part[e] + part[128 + e]) + (part[256 + e] + part[384 + e]));
        const float den = qk + dec * qn;
        hval = num / fmaxf(fabsf(den), expf(-mt));
        const float s2 = wave_sum(hval * hval); if ((tid & 63) == 0) sred[4 + (tid >> 6)] = s2; }
    __syncthreads();
    if (tid < 128) { const float rs = 1.0f / sqrtf((sred[4] + sred[5]) * (1.0f / MD) + RMS_EPS);
        const float o = hval * rs * ((const float*)a.in[11])[h * MD + e] * sigmoidf(bf2f(OM[e]));
        ((bf16*)(ws + WS_MIX))[row * DMODEL + 512 + h * MD + e] = (bf16)f2bf(o); }
    if (tid == 0) a.out[O_MS + u] = mt;
    __syncthreads();
}

__device__ __forceinline__ float small_gemm16(const bf16* A, int lda, const bf16* Wt, int K, int c0, LAS float* red, int tid) {
    const int lane = tid & 63, wid = __builtin_amdgcn_readfirstlane(tid >> 6); const int kw = K / NWAVES, kbeg = wid * kw;
    const bf16* ap = A + (size_t)(lane & 15) * lda + kbeg + 8 * (lane >> 4);
    const bf16* bp = Wt + (size_t)(c0 + (lane & 15)) * K + kbeg + 8 * (lane >> 4);
    f32x4 acc0 = {0.f, 0.f, 0.f, 0.f}, acc1 = {0.f, 0.f, 0.f, 0.f};
#pragma unroll 4
    for (int k = 0; k < kw; k += 32) { const bf16x8 a0 = *(const bf16x8*)(ap + k), a1 = *(const bf16x8*)(ap + (size_t)16 * lda + k), bb = *(const bf16x8*)(bp + k); acc0 = mfma16(a0, bb, acc0); acc1 = mfma16(a1, bb, acc1); }
#pragma unroll
    for (int r = 0; r < 4; ++r) { red[(wid * 32 + 4 * (lane >> 4) + r) * 16 + (lane & 15)] = acc0[r]; red[(wid * 32 + 16 + 4 * (lane >> 4) + r) * 16 + (lane & 15)] = acc1[r]; }
    __syncthreads();
    float s = 0.f;
#pragma unroll
    for (int w = 0; w < NWAVES; ++w) s += red[w * 512 + tid];
    __syncthreads();
    return s;
}

__global__ void __launch_bounds__(NTHR, 2) hymba_fwd(Args args) {
    extern __shared__ __attribute__((aligned(16))) unsigned char lds_raw[];
    LAS unsigned char* lds = (LAS unsigned char*)lds_raw;
    volatile LAS unsigned* MISC = (volatile LAS unsigned*)(lds + MISC_OFF);
    const int tid = threadIdx.x;
    const int G = gridDim.x; const int bx = blockIdx.x; const int vcu = (G % 8 == 0) ? (bx % 8) * (G / 8) + bx / 8 : bx;
    unsigned char* ws = args.ws; gu32* ctl = (gu32*)(ws + WS_CTL);
    for (int u = tid; u < (LDS_BYTES - LDSCTL_OFF) / 4; u += NTHR) ((LAS unsigned*)(lds + LDSCTL_OFF))[u] = 0u;
    __syncthreads();
    XcdBarrier bar; bar.bar = (unsigned*)(ctl + CW_BAR); bar.x = 0; bar.st = nullptr;
    if (!MK_PER_PHASE) bar = xcd_barrier_post((unsigned*)(ctl + CW_BAR), MISC + 8);
#define GRID_BAR() do { if (!MK_PER_PHASE) xcd_barrier(bar); } while (0)
    const int lo = args.ph_lo, hi = args.ph_hi;
#ifndef P4_MASK
#define P4_MASK 15
#endif
#ifndef PHASE_MASK
#define PHASE_MASK 0x1ff
#endif
#define IN(k) (((PHASE_MASK >> (k)) & 1) && lo <= (k) && (k) < hi)
#ifndef PROBE_REP
#define PROBE_REP 0
#endif
#define REPS(k) _Pragma("unroll 1") for (int rep_ = 0; rep_ < 1 + ((PROBE_REP >> (k)) & 1); ++rep_)
#define REP_BAR(k) do { if (rep_ + 1 < 1 + ((PROBE_REP >> (k)) & 1)) GRID_BAR(); } while (0)
#define BOTH(k) (IN(k) && IN((k) + 1))
    bf16* WIN_T = (bf16*)(ws + WS_WIN); bf16* WOUT_T = (bf16*)(ws + WS_WOUT); bf16* WUP_T = (bf16*)(ws + WS_WUP); bf16* WDN_T = (bf16*)(ws + WS_WDN);
    bf16* XN = (bf16*)(ws + WS_XN); bf16* ZB = (bf16*)(ws + WS_Z); bf16* MIX = (bf16*)(ws + WS_MIX); bf16* X1B = (bf16*)(ws + WS_X1B); bf16* UB = (bf16*)(ws + WS_U);
    float* X1 = (float*)(ws + WS_X1); float* SSQ1 = (float*)(ws + WS_SSQ1); float* SSQ2 = (float*)(ws + WS_SSQ2); float* GATES = (float*)(ws + WS_GATES);
    float* KMP = (float*)(ws + WS_KMP); float* KMS = (float*)(ws + WS_KMS);
    float* X1S = (float*)(ws + WS_SMALL + SM_X1S); float* X2S = (float*)(ws + WS_SMALL + SM_X2S); bf16* X1SB = (bf16*)(ws + WS_SMALL + SM_X1SB); bf16* USB = (bf16*)(ws + WS_SMALL + SM_US);

    if (IN(0)) { REPS(0) {
        const int lane = tid & 63, wave = __builtin_amdgcn_readfirstlane(tid >> 6);
        LAS float* scr = (LAS float*)(lds + RING_OFF + wave * 16384);
        const int gw = vcu * NWAVES + wave, NGW = G * NWAVES;
        constexpr int I_IN = (DMODEL / 64) * (NZ / 32), I_OUT = (DMODEL / 64) * (DMODEL / 32), I_UP = (DMODEL / 64) * (FF / 32), I_DN = (FF / 64) * (DMODEL / 32);
        for (int it = gw; it < I_IN + I_OUT + I_UP + I_DN; it += NGW) {
            int r = it;
            if (r < I_IN) { p0_transpose_item((const float*)args.in[9], DMODEL, NIN, NZ / 32, WIN_T, nullptr, scr, r, lane); continue; } r -= I_IN;
            if (r < I_OUT) { p0_transpose_item((const float*)args.in[12], DMODEL, DMODEL, DMODEL / 32, WOUT_T, nullptr, scr, r, lane); continue; } r -= I_OUT;
            if (r < I_UP) { p0_transpose_item((const float*)args.in[14], DMODEL, FF, FF / 32, WUP_T, (const float*)args.in[13], scr, r, lane); continue; } r -= I_UP;
            p0_transpose_item((const float*)args.in[15], FF, DMODEL, DMODEL / 32, WDN_T, nullptr, scr, r, lane);
        }
        p0_rows(args, XN, GATES, gw, NGW, lane);
        __syncthreads();
        for (int u = vcu; u < SB * 32; u += G) p0_kmean_unit((const float*)args.in[2], (const int*)args.in[4], KMS, u, (LAS float*)(lds + RING_OFF), tid);
        REP_BAR(0); }
        if (BOTH(0)) GRID_BAR();
    }

    if (IN(1)) { REPS(1) {
        pg8::Gemm g{XN, WIN_T, MPAD, NZ, DMODEL}; pg8::StaticOrder S; S.init(MPAD, NZ, G, bx);
        pg8::EpiZ E{ZB, Z_STRIDE_B / 2, attn_body::C2, args.out + O_KP, args.out + O_VP, args.out + O_KS, args.out + O_VS, rep_ == 0 ? KMP : (float*)(ws + WS_U)};
        pg8::gemm_phase<pg8::EpiZ, pg8::StaticOrder, true, true>(lds + RING_OFF, g, S, E);
        REP_BAR(1); }
        if (BOTH(1)) GRID_BAR();
    }

    if (IN(2)) { REPS(2) {
        for (int i = vcu * NTHR + tid; i < 32 * 32 * 64; i += G * NTHR) { const int bh8 = i >> 11, j = (i >> 6) & 31, d = i & 63, b = bh8 >> 3, h = bh8 & 7;
            const float v = (j < 16) ? KMP[((size_t)(b * 16 + j)) * 512 + h * AD + d] : 0.f;
            ((bf16*)(ws + WS_SMALL + SM_KMB))[((size_t)bh8 * 64 + j) * 64 + d] = (bf16)f2bf(v); }
        for (int u = vcu; u < 16 * NCH; u += G) ml_local_unit(ws, lds, u, tid);
        REP_BAR(2); }
        if (BOTH(2)) GRID_BAR();
    }

    if (IN(3)) { REPS(3) {
        for (int u = vcu; u < 256; u += G) ml_scan_unit(args, lds, u, tid);
        REP_BAR(3); }
        if (BOTH(3)) GRID_BAR();
    }

    if (IN(4)) { REPS(4) {
        if ((P4_MASK & 1) && (args.sub & 1)) for (int v = vcu; v < 256; v += G) {
            const int bh = v >> 3, s = v & 7;
#pragma unroll 1
            for (int i = 0; i < 2; ++i) attn_body::attn_unit<8>(bh >> 3, bh & 7, i == 0 ? s : 15 - s, (const attn_body::bf16*)ZB, (const attn_body::bf16*)(ZB + Z_STRIDE_B / 2), (const attn_body::bf16*)(ZB + Z_STRIDE_B),
                                                                   (attn_body::bf16*)MIX, (const attn_body::bf16*)(ws + WS_SMALL + SM_KMB), (char*)lds_raw + RING_OFF);
        }
        __syncthreads();
        if ((P4_MASK & 2) && (args.sub & 2)) for (int u = vcu; u < 16 * NCH; u += G) ml_out_unit(args, lds, u, tid);
        if ((P4_MASK & 4) && (args.sub & 4)) for (int u = vcu; u < SB * AH; u += G) dec_attn_unit(args, lds, u, tid);
        if ((P4_MASK & 8) && (args.sub & 8)) for (int u = vcu; u < SB * MH; u += G) dec_mlstm_unit(args, lds, u, tid);
        REP_BAR(4); }
        if (BOTH(4)) GRID_BAR();
    }

    if (IN(5)) { REPS(5) {
        pg8::Gemm g{MIX, WOUT_T, MP, DMODEL, DMODEL}; pg8::StaticOrder S; S.init(MP, DMODEL, G, bx);
        pg8::EpiRes E{(const float*)args.in[0], X1, X1B, SSQ1};
        pg8::gemm_phase<pg8::EpiRes, pg8::StaticOrder, true, true>(lds + RING_OFF, g, S, E);
        for (int cu = vcu; cu < 64; cu += G) { const float v = small_gemm16(MIX + (size_t)MP * DMODEL, DMODEL, WOUT_T, DMODEL, cu * 16, (LAS float*)(lds + RING_OFF), tid);
            const int r = tid >> 4, c = cu * 16 + (tid & 15); const float x1 = ((const float*)args.in[1])[r * DMODEL + c] + v; X1S[r * DMODEL + c] = x1; X1SB[r * DMODEL + c] = (bf16)f2bf(x1); }
        REP_BAR(5); }
        if (BOTH(5)) GRID_BAR();
    }

    if (IN(6)) { REPS(6) {
        pg8::Gemm g{X1B, WUP_T, MP, FF, DMODEL}; pg8::StaticOrder S; S.init(MP, FF, G, bx);
        pg8::EpiUp E{UB, SSQ1, RMS_EPS};
        pg8::gemm_phase<pg8::EpiUp, pg8::StaticOrder, true, true>(lds + RING_OFF, g, S, E);
        for (int cu = vcu; cu < 256; cu += G) {
            const int r = tid >> 4; float s = 0.f; { const f32x4* xp = (const f32x4*)(X1S + r * DMODEL + (tid & 15) * 64);
#pragma unroll 4
                for (int i = 0; i < 16; ++i) { const f32x4 x = xp[i]; s += (x[0] * x[0] + x[1] * x[1]) + (x[2] * x[2] + x[3] * x[3]); } }
            s += __shfl_xor(s, 1); s += __shfl_xor(s, 2); s += __shfl_xor(s, 4); s += __shfl_xor(s, 8);
            const float rs = 1.0f / sqrtf(s * (1.0f / DMODEL) + RMS_EPS);
            const float v = small_gemm16(X1SB, DMODEL, WUP_T, DMODEL, cu * 16, (LAS float*)(lds + RING_OFF), tid);
            const float t = fmaxf(v * rs, 0.f); USB[r * FF + cu * 16 + (tid & 15)] = (bf16)f2bf(t * t); }
        REP_BAR(6); }
        if (BOTH(6)) GRID_BAR();
    }

    if (IN(7)) { REPS(7) {
        pg8::Gemm g{UB, WDN_T, MP, DMODEL, FF}; pg8::StaticOrder S; S.init(MP, DMODEL, G, bx);
        pg8::EpiRes E{X1, args.out + O_Y, nullptr, SSQ2};
        pg8::gemm_phase<pg8::EpiRes, pg8::StaticOrder, true, true>(lds + RING_OFF, g, S, E);
        for (int cu = vcu; cu < 64; cu += G) { const float v = small_gemm16(USB, FF, WDN_T, FF, cu * 16, (LAS float*)(lds + RING_OFF), tid);
            const int r = tid >> 4, c = cu * 16 + (tid & 15); X2S[r * DMODEL + c] = X1S[r * DMODEL + c] + v; }
        REP_BAR(7); }
        if (BOTH(7)) GRID_BAR();
    }

    if (IN(8)) {
        const int lane = tid & 63, wave = __builtin_amdgcn_readfirstlane(tid >> 6);
        const int gw = vcu * NWAVES + wave, NGW = G * NWAVES; const float* lnf = (const float*)args.in[16];
        f32x4 lw[4];
#pragma unroll
        for (int j = 0; j < 4; ++j) lw[j] = *(const f32x4*)(lnf + 4 * lane + 256 * j);
        for (int m = gw; m < MP + SB; m += NGW) {
            const bool pr = m < MP; f32x4* yrow = (f32x4*)(pr ? args.out + O_Y + (size_t)m * DMODEL : args.out + O_YS + (size_t)(m - MP) * DMODEL) + lane;
            const f32x4* xrow = pr ? yrow : (const f32x4*)(X2S + (size_t)(m - MP) * DMODEL) + lane;
            f32x4 v[4]; float s = 0.f;
#pragma unroll
            for (int j = 0; j < 4; ++j) { v[j] = xrow[64 * j]; s += (v[j].x * v[j].x + v[j].y * v[j].y) + (v[j].z * v[j].z + v[j].w * v[j].w); }
            const float rs = 1.0f / sqrtf(wave_sum(s) * (1.0f / DMODEL) + RMS_EPS);
#pragma unroll
            for (int j = 0; j < 4; ++j) yrow[64 * j] = v[j] * rs * lw[j];
        }
    }
#undef IN
#undef BOTH
#undef GRID_BAR
}

extern "C" void kernel_launch(void* const* d_in, const int* in_sizes, int n_in, void* d_out, int out_size, void* d_ws, size_t ws_size, hipStream_t stream) {
    static int grid = 0;
    if (grid == 0) {
        if (n_in != 17 || in_sizes[0] != MP * DMODEL || (size_t)out_size != O_END || ws_size < WS_END) { fprintf(stderr, "kernel_launch: unexpected shapes (n_in %d, in0 %d, out %d, ws %zu); nothing launched\n", n_in, n_in > 0 ? in_sizes[0] : -1, out_size, ws_size); grid = -1; return; }
        int dev = 0, cus = 0, per_cu = 0;
        if (hipGetDevice(&dev) != hipSuccess || hipDeviceGetAttribute(&cus, hipDeviceAttributeMultiprocessorCount, dev) != hipSuccess) { fprintf(stderr, "kernel_launch: device query failed\n"); grid = -1; return; }
        if (hipFuncSetAttribute((const void*)hymba_fwd, hipFuncAttributeMaxDynamicSharedMemorySize, LDS_BYTES) != hipSuccess) { fprintf(stderr, "kernel_launch: hipFuncSetAttribute failed\n"); grid = -1; return; }
        if (hipOccupancyMaxActiveBlocksPerMultiprocessor(&per_cu, (const void*)hymba_fwd, NTHR, LDS_BYTES) != hipSuccess || per_cu < 1) fprintf(stderr, "kernel_launch: note: occupancy query reports %d workgroups per CU\n", per_cu);
        (void)hipGetLastError();
        grid = cus;
    }
    if (grid < 0) return;
    if (hipMemsetAsync((char*)d_ws + WS_CTL, 0, CTL_ZERO_BYTES, stream) != hipSuccess) { fprintf(stderr, "kernel_launch: hipMemsetAsync failed\n"); return; }
    Args a{};
    for (int i = 0; i < 17; ++i) a.in[i] = d_in[i];
    a.out = (float*)d_out; a.ws = (unsigned char*)d_ws;
#if MK_PER_PHASE
    a.sub = 15; for (int p = 0; p < N_PHASES; ++p) { a.ph_lo = p; a.ph_hi = p + 1; hipLaunchKernelGGL(hymba_fwd, dim3(grid), dim3(NTHR), LDS_BYTES, stream, a); }
#else
    a.ph_lo = 0; a.ph_hi = N_PHASES; a.sub = 15; hipLaunchKernelGGL(hymba_fwd, dim3(grid), dim3(NTHR), LDS_BYTES, stream, a);
#if PROBE_EXTRA_PHASE >= 0
    a.ph_lo = PROBE_EXTRA_PHASE; a.ph_hi = PROBE_EXTRA_PHASE + 1; a.sub = PROBE_EXTRA_SUB; hipLaunchKernelGGL(hymba_fwd, dim3(grid), dim3(NTHR), LDS_BYTES, stream, a);
#if PROBE_EXTRA_PHASE2 >= 0
    a.ph_lo = PROBE_EXTRA_PHASE2; a.ph_hi = PROBE_EXTRA_PHASE2 + 1; a.sub = 15; hipLaunchKernelGGL(hymba_fwd, dim3(grid), dim3(NTHR), LDS_BYTES, stream, a);
#endif
#endif
#endif
    const hipError_t le = hipPeekAtLastError();
    if (le != hipSuccess) fprintf(stderr, "kernel_launch: launch failed: %s\n", hipGetErrorName(le));
}
```
